# Optimizing an MI355X kernel written in HIP

```python
import jax
import jax.numpy as jnp
from jax import lax
import numpy as np

D_MODEL = 2048
BATCH = 4
SEQ = 4096
DEPTH = 1

HEAD_DIM = 128
ATT_GROUPS = ((128, 1), (512, 4), (2048, 16))
ATT_HEADS_PER_GROUP = 4
ATT_HEADS = ATT_HEADS_PER_GROUP * len(ATT_GROUPS)
ATT_WIDTH = ATT_HEADS * HEAD_DIM
ATT_OUT_WIDTH = ATT_HEADS_PER_GROUP * HEAD_DIM
ATT_BLOCK = 128
HGRN_HEADS = 8
HGRN_DK = 128
HGRN_DV = 128
HGRN_WIDTH = HGRN_HEADS * HGRN_DK
HGRN_CHUNK = 64
N_EXPERTS = 64
N_GROUPS = 8
TOPK_GROUPS = 4
TOP_K = 8
D_EXPERT = 512
D_SHARED = 512
ROUTED_SCALE = 2.5
MOE_BLOCK = 128
NORM_EPS = 1e-6
IN_COLS = 3 * ATT_WIDTH + 4 * HGRN_WIDTH + 2 * D_MODEL

kernel_name = 'hybrid_dilated_attn_hgrn2_moe_block'


def rmsnorm(a, gain):
    af = a.astype(jnp.float32)
    y = af * lax.rsqrt(jnp.mean(af * af, axis=-1, keepdims=True) + NORM_EPS)
    return (y * gain.astype(jnp.float32)).astype(a.dtype)


def modulate(a, shift, scale):
    return a * (1.0 + scale[:, None, :]) + shift[:, None, :]


def alibi_slopes():
    h = jnp.arange(1, ATT_HEADS + 1, dtype=jnp.float32)
    return jnp.exp2(-8.0 * h / ATT_HEADS)


def dilated_window_attention(q, k, v, window, dilation, slopes):
    B, H, S, hd = q.shape
    w_sub = window // dilation
    L = S // dilation
    nb = -(-L // ATT_BLOCK)
    Lp = nb * ATT_BLOCK

    def to_blocks(a):
        a = a.reshape(B, H, L, dilation, hd).transpose(0, 1, 3, 2, 4)
        a = jnp.pad(a, ((0, 0), (0, 0), (0, 0), (0, Lp - L), (0, 0)))
        return a.reshape(B, H, dilation, nb, ATT_BLOCK, hd)

    qb, kb, vb = to_blocks(q), to_blocks(k), to_blocks(v)

    def with_prev(a):
        prev = jnp.pad(a[:, :, :, :-1], ((0, 0), (0, 0), (0, 0), (1, 0), (0, 0), (0, 0)))
        return jnp.concatenate([prev, a], axis=4)

    kk, vv = with_prev(kb), with_prev(vb)
    s = jnp.einsum('bhrnqd,bhrnkd->bhrnqk', qb, kk, preferred_element_type=jnp.float32) * (hd ** -0.5)
    qi = jnp.arange(ATT_BLOCK)[:, None]
    ki = jnp.arange(2 * ATT_BLOCK)[None, :]
    j = qi + ATT_BLOCK - ki
    key_pos = jnp.arange(nb)[:, None, None] * ATT_BLOCK + ki[None] - ATT_BLOCK
    valid = (j >= 0) & (j <= w_sub) & (key_pos >= 0)
    dist = (dilation * j).astype(jnp.float32)
    s = s - slopes.astype(jnp.float32)[None, :, None, None, None, None] * dist
    s = jnp.where(valid, s, -jnp.inf)
    lse = jax.nn.logsumexp(s, axis=-1)
    p = jnp.exp(s - lse[..., None])
    o = jnp.einsum('bhrnqk,bhrnkd->bhrnqd', p, vv.astype(jnp.float32))
    o = o.reshape(B, H, dilation, Lp, hd)[:, :, :, :L].transpose(0, 1, 3, 2, 4).reshape(B, H, S, hd)
    lse = lse.reshape(B, H, dilation, Lp)[:, :, :, :L].transpose(0, 1, 3, 2).reshape(B, H, S)
    return o, lse


def hgrn2_chunkwise(q, k, v, log_f):
    B, H, S, dk = q.shape
    dv = v.shape[-1]
    n_chunks = S // HGRN_CHUNK

    def to_chunks(a):
        return a.reshape(B, H, n_chunks, HGRN_CHUNK, a.shape[-1]).transpose(2, 0, 1, 3, 4)

    causal = jnp.tril(jnp.ones((HGRN_CHUNK, HGRN_CHUNK), dtype=bool))[:, :, None]

    def step(state, inp):
        qc, kc, vc, gc = inp
        b = jnp.cumsum(gc, axis=2)
        o_inter = jnp.einsum('bhtk,bhkv->bhtv', qc * jnp.exp(b), state)
        rel = b[:, :, :, None, :] - b[:, :, None, :, :]
        decay = jnp.exp(jnp.where(causal, rel, -jnp.inf))
        scores = jnp.einsum('bhtk,bhsk,bhtsk->bhts', qc, kc, decay)
        o_intra = jnp.einsum('bhts,bhsv->bhtv', scores, vc)
        b_last = b[:, :, -1:, :]
        state = (jnp.exp(b_last[:, :, 0, :])[..., None] * state
                 + jnp.einsum('bhsk,bhsv->bhkv', kc * jnp.exp(b_last - b), vc))
        return state, o_inter + o_intra

    state0 = jnp.zeros((B, H, dk, dv), jnp.float32)
    _, o = lax.scan(step, state0, (to_chunks(q), to_chunks(k), to_chunks(v), to_chunks(log_f)))
    return o.transpose(1, 2, 0, 3, 4).reshape(B, H, S, dv)


def moe_ffn(h, w_router, router_bias, w_gate_e, w_up_e, w_down_e, w_gate_s, w_up_s, w_down_s):
    B, S, D = h.shape
    T = B * S
    xt = h.reshape(T, D)
    scores = jax.nn.sigmoid((xt @ w_router).astype(jnp.float32))
    choice = scores + router_bias.astype(jnp.float32)
    per_group = N_EXPERTS // N_GROUPS
    group_score = lax.top_k(choice.reshape(T, N_GROUPS, per_group), 2)[0].sum(-1)
    _, top_groups = lax.top_k(group_score, TOPK_GROUPS)
    group_mask = jnp.any(top_groups[:, :, None] == jnp.arange(N_GROUPS)[None, None, :], axis=1)
    expert_mask = jnp.repeat(group_mask, per_group, axis=1)
    _, top_idx = lax.top_k(jnp.where(expert_mask, choice, -jnp.inf), TOP_K)
    gate = jnp.take_along_axis(scores, top_idx, axis=1)
    gate = gate / jnp.sum(gate, axis=1, keepdims=True) * ROUTED_SCALE

    n_assign = T * TOP_K
    n_blocks = -(-n_assign // MOE_BLOCK) + N_EXPERTS
    flat_e = top_idx.reshape(-1)
    flat_tok = jnp.repeat(jnp.arange(T, dtype=jnp.int32), TOP_K)
    flat_w = gate.reshape(-1)
    order = jnp.argsort(flat_e)
    e_sorted = flat_e[order]
    counts = jax.ops.segment_sum(jnp.ones_like(flat_e), flat_e, num_segments=N_EXPERTS)
    starts = jnp.cumsum(counts) - counts
    padded = (counts + MOE_BLOCK - 1) // MOE_BLOCK * MOE_BLOCK
    pad_end = jnp.cumsum(padded)
    dest = (pad_end - padded)[e_sorted] + jnp.arange(n_assign, dtype=jnp.int32) - starts[e_sorted]
    slot_tok = jnp.full((n_blocks * MOE_BLOCK,), T, jnp.int32).at[dest].set(flat_tok[order])
    slot_w = jnp.zeros((n_blocks * MOE_BLOCK,), jnp.float32).at[dest].set(flat_w[order])
    block_start = jnp.arange(n_blocks, dtype=jnp.int32) * MOE_BLOCK
    block_expert = jnp.minimum(jnp.searchsorted(pad_end, block_start, side='right'), N_EXPERTS - 1)
    x_pad = jnp.concatenate([xt, jnp.zeros((1, D), xt.dtype)], axis=0)

    def expert_block(acc, blk):
        tok, wts, e = blk
        xb = x_pad[tok]
        hid = jax.nn.silu(xb @ w_gate_e[e]) * (xb @ w_up_e[e])
        yb = (hid @ w_down_e[e]).astype(jnp.float32) * wts[:, None]
        return acc.at[tok].add(yb), None

    acc, _ = lax.scan(expert_block, jnp.zeros((T + 1, D), jnp.float32),
                      (slot_tok.reshape(n_blocks, MOE_BLOCK), slot_w.reshape(n_blocks, MOE_BLOCK), block_expert))
    shared = (jax.nn.silu(xt @ w_gate_s) * (xt @ w_up_s)) @ w_down_s
    return (acc[:T] + shared.astype(jnp.float32)).astype(h.dtype).reshape(B, S, D)


def hybrid_layer(x, c, lb, w_ada, b_ada, pre_norm_mix, post_norm_mix, w_in, hgrn_norm,
                 w_branch_attn, w_branch_hgrn, w_out, pre_norm_ffn, post_norm_ffn,
                 w_router, router_bias, w_gate_e, w_up_e, w_down_e, w_gate_s, w_up_s, w_down_s):
    B, S, D = x.shape
    mod = jax.nn.silu(c) @ w_ada + b_ada
    shift_m, scale_m, gate_m, shift_f, scale_f, gate_f = jnp.split(mod, 6, axis=-1)

    h = modulate(rmsnorm(x, pre_norm_mix), shift_m, scale_m)
    proj = h @ w_in
    cuts = [int(v) for v in np.cumsum([ATT_WIDTH] * 3 + [HGRN_WIDTH] * 4 + [D_MODEL])]
    q_a, k_a, v_a, q_r, f_r, i_r, g_r, gate_a, gate_b = jnp.split(proj, cuts, axis=-1)

    def att_heads(a):
        return a.reshape(B, S, ATT_HEADS, HEAD_DIM).transpose(0, 2, 1, 3)
    qh, kh, vh = att_heads(q_a), att_heads(k_a), att_heads(v_a)
    slopes = alibi_slopes()
    outs, lses = [], []
    for g, (window, dilation) in enumerate(ATT_GROUPS):
        sl = slice(g * ATT_HEADS_PER_GROUP, (g + 1) * ATT_HEADS_PER_GROUP)
        o_g, lse_g = dilated_window_attention(qh[:, sl], kh[:, sl], vh[:, sl], window, dilation, slopes[sl])
        outs.append(o_g)
        lses.append(lse_g)
    mix_w = jax.nn.softmax(jnp.stack(lses, axis=0), axis=0)
    o_att = jnp.sum(mix_w[..., None] * jnp.stack(outs, axis=0), axis=0)
    o_att = o_att.transpose(0, 2, 1, 3).reshape(B, S, ATT_OUT_WIDTH).astype(x.dtype)

    f = lb + (1.0 - lb) * jax.nn.sigmoid(f_r.astype(jnp.float32))
    def rec_heads(a):
        return a.reshape(B, S, HGRN_HEADS, -1).transpose(0, 2, 1, 3)
    o_rec = hgrn2_chunkwise(rec_heads(q_r.astype(jnp.float32)), rec_heads(1.0 - f),
                            rec_heads(i_r.astype(jnp.float32)), rec_heads(jnp.log(f)))
    o_rec = rmsnorm(o_rec, hgrn_norm.reshape(HGRN_HEADS, 1, HGRN_DV))
    o_rec = o_rec.transpose(0, 2, 1, 3).reshape(B, S, HGRN_HEADS * HGRN_DV).astype(x.dtype) * jax.nn.silu(g_r)

    merged = jax.nn.sigmoid(gate_a) * (o_att @ w_branch_attn) + jax.nn.sigmoid(gate_b) * (o_rec @ w_branch_hgrn)
    y = merged @ w_out
    x = x + gate_m[:, None, :] * rmsnorm(y, post_norm_mix)

    h2 = modulate(rmsnorm(x, pre_norm_ffn), shift_f, scale_f)
    y2 = moe_ffn(h2, w_router, router_bias, w_gate_e, w_up_e, w_down_e, w_gate_s, w_up_s, w_down_s)
    x = x + gate_f[:, None, :] * rmsnorm(y2, post_norm_ffn)
    return x


def setup_inputs(seed: int = 0) -> dict:
    key = jax.random.key(seed)
    ks = jax.random.split(key, 22)
    L, D = DEPTH, D_MODEL

    def nrm(k, shape, scale):
        return jax.random.normal(k, shape, jnp.float32) * scale

    return {
        'x': nrm(ks[0], (BATCH, SEQ, D), 1.0),
        'c': nrm(ks[1], (BATCH, D), 1.0),
        'w_ada': nrm(ks[2], (L, D, 6 * D), 0.5 * D ** -0.5),
        'b_ada': nrm(ks[3], (L, 6 * D), 0.02),
        'pre_norm_mix': 1.0 + nrm(ks[4], (L, D), 0.1),
        'post_norm_mix': 1.0 + nrm(ks[5], (L, D), 0.1),
        'w_in': nrm(ks[6], (L, D, IN_COLS), D ** -0.5),
        'hgrn_lb_logits': nrm(ks[7], (DEPTH + 1, HGRN_WIDTH), 0.5),
        'hgrn_norm': 1.0 + nrm(ks[8], (L, HGRN_HEADS * HGRN_DV), 0.1),
        'w_branch_attn': nrm(ks[9], (L, ATT_OUT_WIDTH, D), ATT_OUT_WIDTH ** -0.5),
        'w_branch_hgrn': nrm(ks[10], (L, HGRN_HEADS * HGRN_DV, D), (HGRN_HEADS * HGRN_DV) ** -0.5),
        'w_out': nrm(ks[11], (L, D, D), D ** -0.5),
        'pre_norm_ffn': 1.0 + nrm(ks[12], (L, D), 0.1),
        'post_norm_ffn': 1.0 + nrm(ks[13], (L, D), 0.1),
        'w_router': nrm(ks[14], (L, D, N_EXPERTS), D ** -0.5),
        'router_bias': nrm(ks[15], (L, N_EXPERTS), 0.01),
        'w_gate_e': nrm(ks[16], (L, N_EXPERTS, D, D_EXPERT), D ** -0.5),
        'w_up_e': nrm(ks[17], (L, N_EXPERTS, D, D_EXPERT), D ** -0.5),
        'w_down_e': nrm(ks[18], (L, N_EXPERTS, D_EXPERT, D), D_EXPERT ** -0.5),
        'w_gate_s': nrm(ks[19], (L, D, D_SHARED), D ** -0.5),
        'w_up_s': nrm(ks[20], (L, D, D_SHARED), D ** -0.5),
        'w_down_s': nrm(ks[21], (L, D_SHARED, D), D_SHARED ** -0.5),
    }


def reference(x, c, w_ada, b_ada, pre_norm_mix, post_norm_mix, w_in, hgrn_lb_logits, hgrn_norm,
              w_branch_attn, w_branch_hgrn, w_out, pre_norm_ffn, post_norm_ffn, w_router, router_bias,
              w_gate_e, w_up_e, w_down_e, w_gate_s, w_up_s, w_down_s):
    lb_table = jnp.cumsum(jax.nn.softmax(hgrn_lb_logits.astype(jnp.float32), axis=0), axis=0)
    for l in range(DEPTH):
        x = hybrid_layer(x, c, lb_table[l], w_ada[l], b_ada[l], pre_norm_mix[l], post_norm_mix[l], w_in[l],
                         hgrn_norm[l], w_branch_attn[l], w_branch_hgrn[l], w_out[l], pre_norm_ffn[l],
                         post_norm_ffn[l], w_router[l], router_bias[l], w_gate_e[l], w_up_e[l], w_down_e[l],
                         w_gate_s[l], w_up_s[l], w_down_s[l])
    return x
```

```cpp
#include <hip/hip_runtime.h>
#include <cstdio>
#include <cstdint>

#ifndef N_CONV_WG
#define N_CONV_WG 38
#endif
#ifndef MK_N_LAUNCHES
#define MK_N_LAUNCHES 1
#endif

#define GAS __attribute__((address_space(1)))
#define LAS __attribute__((address_space(3)))
typedef unsigned short bf16;
typedef short bf16x8 __attribute__((ext_vector_type(8)));
typedef float f32x4 __attribute__((ext_vector_type(4)));
typedef float f32x2 __attribute__((ext_vector_type(2)));
typedef unsigned u32x4 __attribute__((ext_vector_type(4)));
typedef unsigned u32x2 __attribute__((ext_vector_type(2)));
typedef int i32x4 __attribute__((ext_vector_type(4)));

constexpr int NB = 4, SEQ = 4096, T = NB * SEQ, D = 2048;
constexpr int ATT_W = 1536, INC = 12800, HW = 1024;
constexpr int NE = 64, TOPK = 8, DE = 512;
constexpr int NSLOT = T * TOPK + T;
constexpr float EPS = 1e-6f;
constexpr float SC_GU = 256.f, SC_D = 128.f, SC_YS = 16.f, SC_M = 16.f;
constexpr int NPH = 16;

constexpr size_t WS_CTL = 0, CTL_ZERO_BYTES = 64u << 10;
constexpr int CW_BAR = 4096;
constexpr int CW_CNT = 8192;
constexpr int CW_Q = 8192 + 256;
constexpr int CW_DONE = 8192 + 512;
constexpr size_t WS_MODP = 1u << 20;
constexpr size_t WS_MODF = WS_MODP + (size_t)16 * 4 * 12288 * 4;
constexpr size_t WS_TOPI = WS_MODF + (size_t)4 * 12288 * 4;
constexpr size_t WS_TOPW = WS_TOPI + (size_t)T * 8 * 4;
constexpr size_t WS_TOPP = WS_TOPW + (size_t)T * 8 * 4;
constexpr size_t WS_SLOT_TOK = WS_TOPP + (size_t)T * 8 * 4;
constexpr size_t WS_SLOT_W = WS_SLOT_TOK + (size_t)NSLOT * 4;
constexpr size_t WS_TOK_SLOT = WS_SLOT_W + (size_t)NSLOT * 4;
constexpr size_t WS_TT = WS_TOK_SLOT + (size_t)T * 8 * 4;
constexpr size_t WS_WR = WS_TT + 1024 * 16;
constexpr size_t WS_WGU = 9u << 20;
constexpr size_t WS_WD = WS_WGU + (size_t)65 * 1024 * 2048;
constexpr size_t WS_ARENA = WS_WD + (size_t)65 * 2048 * 512;
static_assert(WS_WR + 256 * 2048 * 2 <= WS_WGU, "small region");
constexpr size_t A_WTIN = 0;
constexpr size_t A_H = A_WTIN + (size_t)INC * D * 2;
constexpr size_t A_QKV = A_H + (size_t)T * D * 2;
constexpr size_t A_MERGED = A_QKV;
constexpr size_t A_QR = A_QKV + (size_t)T * 4608 * 2;
constexpr size_t A_IR = A_QR + (size_t)T * HW * 2;
constexpr size_t A_LF = A_IR + (size_t)T * HW * 2;
constexpr size_t A_Y = A_QR;
constexpr size_t A_GR = A_LF + (size_t)T * HW * 4;
constexpr size_t A_SA = A_GR + (size_t)T * HW * 2;
constexpr size_t A_SB = A_SA + (size_t)T * D * 2;
constexpr size_t A_OATT = A_SB + (size_t)T * D * 2;
constexpr size_t A_OREC = A_OATT + (size_t)T * 512 * 2;
constexpr size_t A_LSE = A_OREC + (size_t)T * HW * 2;
constexpr size_t A_WBA = A_LSE + (size_t)T * 12 * 4;
constexpr size_t A_WBH = A_WBA + (size_t)2048 * 512 * 2;
constexpr size_t A_WOUT = A_WBH + (size_t)2048 * 1024 * 2;
constexpr size_t A_DEC = A_WOUT + (size_t)2048 * 2048 * 2;
constexpr size_t A_O12 = A_DEC + (size_t)2048 * 128 * 4;
constexpr size_t A_H8 = A_O12 + (size_t)T * ATT_W * 2;
constexpr size_t A_WG8 = A_H8 + (size_t)T * D;
constexpr size_t A_X1 = A_WG8 + (size_t)4096 * D;
constexpr size_t A_END1 = A_X1 + (size_t)T * D * 2;
constexpr size_t A_HID = 0;
constexpr size_t A_YS = A_HID + (size_t)NSLOT * DE * 2;
constexpr size_t A_H2 = A_SA;
constexpr size_t A_H2F = A_SB;
constexpr size_t A_RL = 0;
constexpr size_t A_END2 = A_YS + (size_t)NSLOT * D * 2;
constexpr size_t A_LIST = (A_END1 > A_END2 ? A_END1 : A_END2);
constexpr size_t WS_END = WS_ARENA + A_LIST + (size_t)NE * T * 4;
static_assert(A_Y + (size_t)T * D * 4 <= A_GR, "Y overlay");
static_assert(A_H2 >= A_Y + (size_t)T * D * 4 && A_H2 + (size_t)T * D * 2 <= A_END2, "H2 placement");
static_assert(WS_END <= 1187639552ull, "workspace budget (sum of inputs)");

constexpr int RING_BYTES = 131072;
constexpr int LDS_BYTES = 163840;
constexpr int MISC_OFF = LDS_BYTES - 256;

#define RLX_AGENT __ATOMIC_RELAXED, __HIP_MEMORY_SCOPE_AGENT
typedef __bf16 bf16x2_t __attribute__((ext_vector_type(2)));
__device__ __forceinline__ unsigned cvt_pk_bf16(float lo, float hi) { const f32x2 v = {lo, hi}; const bf16x2_t r = __builtin_convertvector(v, bf16x2_t); return __builtin_bit_cast(unsigned, r); }
__device__ __forceinline__ unsigned pk4_gate(const f32x4 s) { const unsigned a = (unsigned)(fmaxf(s[0] * 255.f, 1.f) + 0.5f), b = (unsigned)(fmaxf(s[1] * 255.f, 1.f) + 0.5f), c = (unsigned)(fmaxf(s[2] * 255.f, 1.f) + 0.5f), d = (unsigned)(fmaxf(s[3] * 255.f, 1.f) + 0.5f);
    return a | (b << 8) | (c << 16) | (d << 24); }
__device__ __forceinline__ f32x4 up4_gate(unsigned w) { return (f32x4){(float)(w & 0xffu), (float)((w >> 8) & 0xffu), (float)((w >> 16) & 0xffu), (float)(w >> 24)}; }
__device__ __forceinline__ unsigned pk4_fp8(float a, float b, float c, float d) { int w = __builtin_amdgcn_cvt_pk_fp8_f32(a, b, 0, false); w = __builtin_amdgcn_cvt_pk_fp8_f32(c, d, w, true); return (unsigned)w; }
__device__ __forceinline__ float bf2f(unsigned short b) { return __uint_as_float(((unsigned)b) << 16); }
__device__ __forceinline__ float bflo(unsigned w) { return __uint_as_float(w << 16); }
__device__ __forceinline__ float bfhi(unsigned w) { return __uint_as_float(w & 0xffff0000u); }
__device__ __forceinline__ float sigmoidf_(float v) { return __builtin_amdgcn_rcpf(1.0f + __expf(-v)); }
__device__ __forceinline__ float siluf_(float v) { return v * sigmoidf_(v); }
typedef short s16x4 __attribute__((ext_vector_type(4)));
__device__ __forceinline__ s16x4 tr_read4(const LAS unsigned char* p) { return __builtin_amdgcn_ds_read_tr16_b64_v4i16((LAS s16x4*)p); }
__device__ __forceinline__ float wave_sum(float v) {
#pragma unroll
    for (int o = 1; o < 64; o <<= 1) v += __shfl_xor(v, o);
    return v;
}
__device__ __forceinline__ float wave_max(float v) {
#pragma unroll
    for (int o = 1; o < 64; o <<= 1) v = fmaxf(v, __shfl_xor(v, o));
    return v;
}

#define XB_TMO      128
#define XB_XCNT(j)  (256  + 64 * (j))
#define XB_XSUB(j)  (1280 + 64 * (j))
#define XB_XGEN(j)  (2304 + 64 * (j))
#define XB_TOP      3328
#define XB_TOPGEN   3392
#define XCD_BAR_WORDS 3456
#define XB_SPIN_CAP (1u << 18)
__device__ __forceinline__ unsigned xb_ld(unsigned* p)              { return __hip_atomic_load(p, __ATOMIC_RELAXED, __HIP_MEMORY_SCOPE_AGENT); }
__device__ __forceinline__ unsigned xb_add(unsigned* p, unsigned v) { return __hip_atomic_fetch_add(p, v, __ATOMIC_RELAXED, __HIP_MEMORY_SCOPE_AGENT); }
__device__ __forceinline__ unsigned xb_xcc_id() { return (unsigned)__builtin_amdgcn_s_getreg((3 << 11) | 20) & 0xFu; }
#define XB_SPIN(cond, bar) do { unsigned _sp = 0; while (cond) { __builtin_amdgcn_s_sleep(1); \
    if ((++_sp & 255u) == 0u) { if (xb_ld(&(bar)[XB_TMO])) break; if (_sp > XB_SPIN_CAP) { atomicAdd(&(bar)[XB_TMO], 1u); break; } } } } while (0)
struct XcdBarrier { unsigned* bar; unsigned x; volatile LAS unsigned* st; };
__device__ __forceinline__ XcdBarrier xcd_barrier_post(unsigned* bar, volatile LAS unsigned* st) {
    XcdBarrier b; b.bar = bar; b.x = xb_xcc_id(); b.st = st;
    if (threadIdx.x == 0) (void)xb_add(&bar[XB_XCNT(b.x)], 1u);
    return b;
}
__device__ __forceinline__ void xcd_barrier_complete(unsigned* bar, unsigned x, unsigned& nloc, unsigned& nx) {
    const unsigned G = gridDim.x * gridDim.y * gridDim.z;
    unsigned sum, cnt, mine, sp = 0u;
    for (;;) {
        sum = 0u; cnt = 0u; mine = 0u;
#pragma unroll
        for (unsigned j = 0; j < 16; ++j) { const unsigned c = xb_ld(&bar[XB_XCNT(j)]); sum += c; cnt += (c > 0u) ? 1u : 0u; mine = (j == x) ? c : mine; }
        if (sum == G) break;
        __builtin_amdgcn_s_sleep(1);
        if ((++sp & 255u) == 0u) { if (xb_ld(&bar[XB_TMO])) break; if (sp > XB_SPIN_CAP) { atomicAdd(&bar[XB_TMO], 1u); break; } }
    }
    nloc = mine > 0u ? mine : 1u; nx = 0u;
#pragma unroll
    for (unsigned j = 0; j < 16; ++j) nx |= (xb_ld(&bar[XB_XCNT(j)]) > 0u ? 1u : 0u) << j;
    if (nx == 0u) nx = 1u;
}
__device__ __forceinline__ void xcd_barrier(const XcdBarrier& b) {
    asm volatile("s_waitcnt vmcnt(0)" ::: "memory");
    __syncthreads();
    if (threadIdx.x == 0) {
        unsigned* bar = b.bar;
        __builtin_amdgcn_s_waitcnt(0);
        unsigned nloc = b.st[0], nx = b.st[1];
        if (nloc == 0u) { xcd_barrier_complete(bar, b.x, nloc, nx); b.st[0] = nloc; b.st[1] = nx; }
        const unsigned old = xb_add(&bar[XB_XSUB(b.x)], 1u);
        const unsigned gen = old / nloc;
        if (old + 1u == (gen + 1u) * nloc) {
            __builtin_amdgcn_fence(__ATOMIC_RELEASE, "agent");
            asm volatile("s_waitcnt vmcnt(0)" ::: "memory");
            const unsigned nxc = (unsigned)__builtin_popcount(nx);
            const unsigned og = xb_add(&bar[XB_TOP], 1u);
            const unsigned tg = og / nxc;
            if (og + 1u == (tg + 1u) * nxc) {
#pragma unroll
                for (unsigned j = 0; j < 16; ++j) if ((nx >> j) & 1u) xb_add(&bar[XB_XGEN(j)], 1u);
            } else XB_SPIN(xb_ld(&bar[XB_XGEN(b.x)]) == gen, bar);
            __builtin_amdgcn_fence(__ATOMIC_ACQUIRE, "agent");
            asm volatile("s_waitcnt vmcnt(0)" ::: "memory");
        } else {
            XB_SPIN(xb_ld(&bar[XB_XGEN(b.x)]) == gen, bar);
            __builtin_amdgcn_fence(__ATOMIC_ACQUIRE, "agent");
            asm volatile("s_waitcnt vmcnt(0)" ::: "memory");
        }
    }
    __syncthreads();
}

namespace pg8 {
constexpr int BM = 256, BK = 64, HALF = 128, HTB = HALF * BK * 2, NXCD = 8, WGM = 8;
__host__ __device__ __forceinline__ int lds_byte(int r, int c) { const int st = (r >> 4) * 2 + (c >> 5), rr = r & 15, cc = c & 31, ob = rr * 64 + cc * 2; return st * 1024 + (ob ^ (((ob >> 9) & 1) << 5)); }
__host__ __device__ __forceinline__ void stage_rc(int b, int& R, int& C) { const int st = b / 1024, sb = b % 1024, swz = sb ^ (((sb >> 9) & 1) << 5); R = (st >> 1) * 16 + swz / 64; C = (st & 1) * 32 + (swz % 64) / 2; }
__host__ __device__ __forceinline__ int perm256(int bj, int R) { const int wc = R >> 5, n = (R >> 4) & 1, fq = (R >> 2) & 3, r = R & 3; return 64 * wc + 16 * fq + 8 * bj + 4 * n + r; }

struct Unit { int row0, pn, e, nvalid, idx; };

__device__ __forceinline__ bool order_tile(int i, int G, int c, int nM, int nN, int& pm, int& pn) {
    const int nwg = nM * nN; const long L = (long)i * G + c; if (L >= nwg) return false;
    int wgid = (int)L; { const int q = nwg / NXCD, r = nwg % NXCD, xcd = wgid % NXCD, off = wgid / NXCD; wgid = (xcd < r ? xcd * (q + 1) : r * (q + 1) + (xcd - r) * q) + off; }
    const int nig = WGM * nN, gid = wgid / nig, fm = gid * WGM, gsz = (nM - fm) < WGM ? (nM - fm) : WGM;
    pm = fm + ((wgid % nig) % gsz); pn = (wgid % nig) / gsz; return true;
}

typedef int i32x8 __attribute__((ext_vector_type(8)));
template <class Epi, class Sched, bool ALIGN_EPI, bool FP8 = false>
__device__ __forceinline__ void gemm_phase(LAS unsigned char* lds, const Sched& S, const Epi& E) {
    const int tid = threadIdx.x, wid = __builtin_amdgcn_readfirstlane(tid >> 6), lane = tid & 63, wr = wid >> 2, wc = wid & 3, fr = lane & 15, fq = lane >> 4;
    const int wscale = S.wscale;
    int nt = S.nt; asm volatile("" : "+s"(nt));
    const unsigned ldb2 = (unsigned)S.ldbB;
    unsigned voffB[2];
#pragma unroll
    for (int i = 0; i < 2; ++i) { int R, C; stage_rc(tid * 16 + i * 8192, R, C); voffB[i] = (unsigned)perm256(0, R) * ldb2 + (unsigned)C * 2u; }
    const size_t hstepB = (size_t)8 * ldb2;
#define PG8_AOFFS(unit) do { int RA_[2], CA2_[2]; _Pragma("unroll") for (int i_ = 0; i_ < 2; ++i_) { int R_, C_; stage_rc((threadIdx.x & 511) * 16 + i_ * 8192, R_, C_); RA_[i_] = R_; CA2_[i_] = C_ * 2; } S.aoffs(unit, RA_, CA2_, voffA); } while (0)
    const size_t kstep = (size_t)(BK * 2);
    const unsigned ldsw = (unsigned)wid * 1024u;
    const int aoff = lds_byte(wr * 64 + fr, fq * 8), boff = lds_byte(wc * 32 + fr, fq * 8);
#define PG8_SA(b, h) (((b) * 2 + (h)) * HTB)
#define PG8_SB(b, h) ((4 + (b) * 2 + (h)) * HTB)
#define PG8_STAGE(bufoff, gbase, voff) do { _Pragma("unroll") for (int _i = 0; _i < 2; ++_i) \
        __builtin_amdgcn_global_load_lds((const unsigned*)((const char*)(gbase) + (voff)[_i]), (LAS unsigned*)(lds + (bufoff) + ldsw + _i * 8192), 16, 0, 0); } while (0)
#define PG8_LDA(dst, b, h) do { _Pragma("unroll") for (int m = 0; m < 4; ++m) _Pragma("unroll") for (int k = 0; k < 2; ++k) dst[m][k] = *(const LAS bf16x8*)(lds + PG8_SA(b, h) + aoff + m * 2048 + k * 1024); } while (0)
#define PG8_LDB(dst, b, h) do { _Pragma("unroll") for (int n = 0; n < 2; ++n) _Pragma("unroll") for (int k = 0; k < 2; ++k) dst[n][k] = *(const LAS bf16x8*)(lds + PG8_SB(b, h) + boff + n * 2048 + k * 1024); } while (0)
#define PG8_MMA(ai, bj, At, Bt) do { __builtin_amdgcn_s_setprio(1); _Pragma("unroll") for (int m = 0; m < 4; ++m) _Pragma("unroll") for (int n = 0; n < 2; ++n) _Pragma("unroll") for (int k = 0; k < 2; ++k) \
        acc[ai][bj][m][n] = __builtin_amdgcn_mfma_f32_16x16x32_bf16(Bt[n][k], At[m][k], acc[ai][bj][m][n], 0, 0, 0); __builtin_amdgcn_s_setprio(0); } while (0)
#define PG8_LDA8(dst, b, h) do { _Pragma("unroll") for (int m = 0; m < 4; ++m) { const i32x4 lo_ = *(const LAS i32x4*)(lds + PG8_SA(b, h) + aoff + m * 2048), hi_ = *(const LAS i32x4*)(lds + PG8_SA(b, h) + aoff + m * 2048 + 1024); \
        dst[m] = __builtin_shufflevector(lo_, hi_, 0, 1, 2, 3, 4, 5, 6, 7); } } while (0)
#define PG8_LDB8(dst, b, h) do { _Pragma("unroll") for (int n = 0; n < 2; ++n) { const i32x4 lo_ = *(const LAS i32x4*)(lds + PG8_SB(b, h) + boff + n * 2048), hi_ = *(const LAS i32x4*)(lds + PG8_SB(b, h) + boff + n * 2048 + 1024); \
        dst[n] = __builtin_shufflevector(lo_, hi_, 0, 1, 2, 3, 4, 5, 6, 7); } } while (0)
#define PG8_MMA8(ai, bj, A8, B8) do { __builtin_amdgcn_s_setprio(1); _Pragma("unroll") for (int m = 0; m < 4; ++m) _Pragma("unroll") for (int n = 0; n < 2; ++n) \
        acc[ai][bj][m][n] = __builtin_amdgcn_mfma_scale_f32_16x16x128_f8f6f4(B8[n], A8[m], acc[ai][bj][m][n], 0, 0, 0, wscale, 0, 0x7F7F7F7F); __builtin_amdgcn_s_setprio(0); } while (0)
#define PG8_XLDA(b, h) do { if constexpr (FP8) PG8_LDA8(At8, b, h); else PG8_LDA(At, b, h); } while (0)
#define PG8_XLDB0(b, h) do { if constexpr (FP8) PG8_LDB8(B08, b, h); else PG8_LDB(B0, b, h); } while (0)
#define PG8_XLDB1(b, h) do { if constexpr (FP8) PG8_LDB8(B18, b, h); else PG8_LDB(B1, b, h); } while (0)
#define PG8_MM0(ai, bj) do { if constexpr (FP8) PG8_MMA8(ai, bj, At8, B08); else PG8_MMA(ai, bj, At, B0); } while (0)
#define PG8_MM1(ai, bj) do { if constexpr (FP8) PG8_MMA8(ai, bj, At8, B18); else PG8_MMA(ai, bj, At, B1); } while (0)
#define PG8_WAIT_V(n) asm volatile("s_waitcnt vmcnt(" #n ")" ::: "memory")
#define PG8_WAIT_L(n) asm volatile("s_waitcnt lgkmcnt(" #n ")" ::: "memory")
#define PG8_BAR __builtin_amdgcn_s_barrier()
#define PG8_SCHED __builtin_amdgcn_sched_barrier(0)
    Unit cur, nxt; int ui = 0;
    if (!S.next(0, cur)) return;
    f32x4 acc[2][2][4][2];
#pragma unroll
    for (int a = 0; a < 2; ++a)
#pragma unroll
        for (int b = 0; b < 2; ++b)
#pragma unroll
            for (int m = 0; m < 4; ++m)
#pragma unroll
                for (int n = 0; n < 2; ++n) acc[a][b][m][n] = (f32x4){0.f, 0.f, 0.f, 0.f};
    bf16x8 At[4][2], B0[2][2], B1[2][2]; i32x8 At8[4], B08[2], B18[2];
    const char* const cA = S.abase();
    const char* cB = S.bptr(cur);
    unsigned voffA[2][2];
    PG8_AOFFS(cur);
    PG8_STAGE(PG8_SB(0, 0), cB, voffB); PG8_STAGE(PG8_SB(0, 1), cB + hstepB, voffB); PG8_STAGE(PG8_SA(0, 0), cA, voffA[0]); PG8_STAGE(PG8_SA(0, 1), cA, voffA[1]);
    if (wr == 1) PG8_BAR;
    PG8_WAIT_V(2); PG8_BAR;
    PG8_STAGE(PG8_SB(1, 0), cB + kstep, voffB); PG8_STAGE(PG8_SA(1, 0), cA + kstep, voffA[0]); PG8_STAGE(PG8_SB(1, 1), cB + hstepB + kstep, voffB);
    PG8_WAIT_V(6); PG8_BAR;
    for (;;) {
        const bool has_next = S.next(ui + 1, nxt);
        const char* nB = has_next ? S.bptr(nxt) : cB;
#define PG8_TRIP() do { \
            const bool last = (t == nt - 2); \
            const char* a1 = cA + (size_t)(t + 1) * kstep; \
            const char* a2 = cA + (last ? (size_t)0 : (size_t)(t + 2) * kstep); const char* b2 = last ? nB : cB + (size_t)(t + 2) * kstep; \
            const char* a3 = a2 + kstep; const char* b3 = b2 + kstep; \
            PG8_XLDB0(0, 0); PG8_XLDB1(0, 1); PG8_SCHED; PG8_XLDA(0, 0); PG8_STAGE(PG8_SA(1, 1), a1, voffA[1]); \
            if (last && has_next) PG8_AOFFS(nxt);        \
            PG8_WAIT_V(8); PG8_WAIT_L(0); PG8_BAR; PG8_MM0(0, 0); PG8_MM1(0, 1); PG8_BAR; PG8_SCHED; \
            PG8_XLDA(0, 1); PG8_STAGE(PG8_SB(0, 0), b2, voffB); PG8_STAGE(PG8_SB(0, 1), b2 + hstepB, voffB); PG8_STAGE(PG8_SA(0, 0), a2, voffA[0]); \
            PG8_WAIT_V(8); PG8_WAIT_L(0); PG8_BAR; PG8_MM0(1, 0); PG8_MM1(1, 1); PG8_BAR; PG8_SCHED; \
            PG8_XLDB0(1, 0); PG8_XLDB1(1, 1); PG8_SCHED; PG8_XLDA(1, 0); PG8_STAGE(PG8_SA(0, 1), a2, voffA[1]); \
            PG8_WAIT_V(8); PG8_WAIT_L(0); PG8_BAR; PG8_MM0(0, 0); PG8_MM1(0, 1); PG8_BAR; PG8_SCHED; \
            PG8_XLDA(1, 1); PG8_STAGE(PG8_SB(1, 0), b3, voffB); PG8_STAGE(PG8_SB(1, 1), b3 + hstepB, voffB); PG8_STAGE(PG8_SA(1, 0), a3, voffA[0]); \
            PG8_WAIT_V(8); PG8_WAIT_L(0); PG8_BAR; PG8_MM0(1, 0); PG8_MM1(1, 1); PG8_BAR; PG8_SCHED; \
        } while (0)
        if constexpr (Epi::MID_T > 0) {
            for (int t = 0; t < Epi::MID_T; t += 2) PG8_TRIP();
            E.mid(acc, cur, wr, wc, fr, fq);
            for (int t = Epi::MID_T; t < nt; t += 2) PG8_TRIP();
        } else {
            for (int t = 0; t < nt; t += 2) PG8_TRIP();
        }
#pragma unroll
        for (int a = 0; a < 2; ++a)
#pragma unroll
            for (int b = 0; b < 2; ++b)
#pragma unroll
                for (int m = 0; m < 4; ++m) asm volatile("" : "+v"(acc[a][b][m][0]), "+v"(acc[a][b][m][1]));
        if constexpr (ALIGN_EPI) { if (wr == 0) PG8_BAR; }
        E(acc, cur, wr, wc, fr, fq);
        if (!has_next) break;
#pragma unroll
        for (int a = 0; a < 2; ++a)
#pragma unroll
            for (int b = 0; b < 2; ++b)
#pragma unroll
                for (int m = 0; m < 4; ++m)
#pragma unroll
                    for (int n = 0; n < 2; ++n) acc[a][b][m][n] = (f32x4){0.f, 0.f, 0.f, 0.f};
        cur = nxt; cB = nB; ++ui;
        if constexpr (ALIGN_EPI) { if (wr == 1) PG8_BAR; }
    }
    PG8_WAIT_V(0);
    if constexpr (!ALIGN_EPI) { if (wr == 0) PG8_BAR; }
    PG8_BAR;
#undef PG8_AOFFS
#undef PG8_TRIP
#undef PG8_SA
#undef PG8_SB
#undef PG8_STAGE
#undef PG8_LDA
#undef PG8_LDB
#undef PG8_MMA
#undef PG8_MMA8
#undef PG8_LDA8
#undef PG8_LDB8
#undef PG8_XLDA
#undef PG8_XLDB0
#undef PG8_XLDB1
#undef PG8_MM0
#undef PG8_MM1
#undef PG8_WAIT_V
#undef PG8_WAIT_L
#undef PG8_BAR
#undef PG8_SCHED
}

struct DenseSched {
    const char* A; const char* Bt; int ldaB, ldbB, nt; int nM, nN, nK, G, c; int wscale = 0x7F7F7F7F;
    __device__ __forceinline__ bool next(int i, Unit& u) const {
        int pm, pn; if (!order_tile(i, G, c, nM, nN * nK, pm, pn)) return false;
        u.row0 = pm * BM; u.nvalid = BM; u.idx = i;
        if (nK > 1) { u.pn = 0; u.e = pn; } else { u.pn = pn; u.e = 0; }
        return true;
    }
    __device__ __forceinline__ const char* abase() const { return A; }
    __device__ __forceinline__ const char* bptr(const Unit& u) const { return Bt + (size_t)u.pn * BM * ldbB + (size_t)u.e * nt * 128; }
    __device__ __forceinline__ void aoffs(const Unit& u, const int (&RA)[2], const int (&CA2)[2], unsigned (&v)[2][2]) const {
#pragma unroll
        for (int h = 0; h < 2; ++h)
#pragma unroll
            for (int i = 0; i < 2; ++i) v[h][i] = (unsigned)(u.row0 + h * HALF + RA[i]) * (unsigned)ldaB + (unsigned)CA2[i] + (unsigned)(u.e * nt * 128);
    }
};
constexpr int MOE_MAXU = 24, MOE_UL_OFF = 131072, MOE_TOK_OFF = 131072 + 512, MOE_ST_OFF = MOE_TOK_OFF + MOE_MAXU * 1024;
__device__ __forceinline__ void moe_tables(const unsigned* cnt, LAS int* ST, int lane) {
    const int c = (int)__hip_atomic_load(cnt + lane, __ATOMIC_RELAXED, __HIP_MEMORY_SCOPE_AGENT), nt_ = (c + 255) >> 8;
    int s = c, tb = nt_;
#pragma unroll
    for (int o = 1; o < 64; o <<= 1) { const int s2 = __shfl_up(s, o), t2 = __shfl_up(tb, o); if (lane >= o) { s += s2; tb += t2; } }
    ST[lane] = s - c; ST[72 + lane] = tb - nt_;
    if (lane == 63) { ST[64] = s; ST[72 + 64] = tb; ST[65] = s + T; ST[72 + 65] = tb + T / 256; }
}
struct MoeSched {
    const char* A; const int* list; const char* Bt; size_t bstride; int ldaB, ldbB, nt, nN; const unsigned* cnt; int NT; int G, c; int wscale; LAS unsigned char* lds;
    __device__ __forceinline__ void prepare() {
        const int tid = threadIdx.x; LAS int* ST = (LAS int*)(lds + MOE_ST_OFF);
        if (tid < 64) moe_tables(cnt, ST, tid);
        __syncthreads();
        NT = __builtin_amdgcn_readfirstlane(ST[72 + 65]);
        if (tid < MOE_MAXU) { int pm, pn; i32x4 ent = (i32x4){-1, 0, 0, 0};
            if (order_tile(tid, G, c, NT, nN, pm, pn)) { int e = 0; while (ST[72 + e + 1] <= pm) ++e;
                const int j = pm - ST[72 + e], ce = ST[e + 1] - ST[e]; ent = (i32x4){e, ST[e] + 256 * j, min(256, ce - 256 * j), pn}; }
            *(LAS i32x4*)(lds + MOE_UL_OFF + tid * 16) = ent; }
        __syncthreads();
        if (list) {
#pragma unroll
            for (int r = 0; r < MOE_MAXU * 256 / 512; ++r) { const int idx = tid + 512 * r, i = idx >> 8, t = idx & 255; const i32x4 ent = *(const LAS i32x4*)(lds + MOE_UL_OFF + i * 16);
                int tok = 0;
                if (ent.x == NE) tok = ent.y - T * 8 + t; else if (ent.x >= 0 && t < ent.z) tok = list[(size_t)ent.x * T + (ent.y - ST[ent.x]) + t];
                *(LAS int*)(lds + MOE_TOK_OFF + idx * 4) = tok; }
        }
        __syncthreads();
    }
    __device__ __forceinline__ bool next(int i, Unit& u) const {
        if (i >= MOE_MAXU) return false;
        const i32x4 ent = *(const LAS i32x4*)(lds + MOE_UL_OFF + i * 16);
        const int ex = __builtin_amdgcn_readfirstlane(ent.x); if (ex < 0) return false;
        u.e = ex; u.row0 = __builtin_amdgcn_readfirstlane(ent.y); u.nvalid = __builtin_amdgcn_readfirstlane(ent.z); u.pn = __builtin_amdgcn_readfirstlane(ent.w); u.idx = i; return true;
    }
    __device__ __forceinline__ const char* abase() const { return A; }
    __device__ __forceinline__ const char* bptr(const Unit& u) const { return Bt + (size_t)u.e * bstride + (size_t)u.pn * BM * ldbB; }
    __device__ __forceinline__ void aoffs(const Unit& u, const int (&RA)[2], const int (&CA2)[2], unsigned (&v)[2][2]) const {
#pragma unroll
        for (int h = 0; h < 2; ++h)
#pragma unroll
            for (int i = 0; i < 2; ++i) { const int rt = h * HALF + RA[i]; int ridx = u.row0 + rt;
                if (list) ridx = *(const LAS int*)(lds + MOE_TOK_OFF + u.idx * 1024 + rt * 4);
                v[h][i] = (unsigned)ridx * (unsigned)ldaB + (unsigned)CA2[i]; }
    }
};

#define EPI_ROWS_BEGIN _Pragma("unroll") for (int ai = 0; ai < 2; ++ai) _Pragma("unroll") for (int m = 0; m < 4; ++m) { const int rt = ai * HALF + wr * 64 + m * 16 + fr; const size_t row = (size_t)(u.row0 + rt);
#define EPI_ROWS_END }
#define EPI_V4(q) acc[ai][(q) >> 1][m][(q) & 1]
__device__ __forceinline__ u32x4 pack8(const f32x4 v0, const f32x4 v1) { u32x4 w; w.x = cvt_pk_bf16(v0[0], v0[1]); w.y = cvt_pk_bf16(v0[2], v0[3]); w.z = cvt_pk_bf16(v1[0], v1[1]); w.w = cvt_pk_bf16(v1[2], v1[3]); return w; }

struct EpiProj {
    static constexpr int MID_T = 0;
    bf16* QKV; bf16* QR; bf16* LF; bf16* IR; bf16* GR; bf16* SA; bf16* SB; const float* lbl; int pn0;
    __device__ __forceinline__ void operator()(const f32x4 (&acc)[2][2][4][2], const Unit& u, int wr, int wc, int fr, int fq) const {
        const int pn = u.pn + pn0; int kind, ldc, colt; bf16* base;
        if (pn < 18)      { kind = 0; base = QKV; ldc = 4608; colt = pn * 256; }
        else if (pn < 22) { kind = 0; base = QR;  ldc = 1024; colt = (pn - 18) * 256; }
        else if (pn < 26) { kind = 3; base = nullptr; ldc = 1024; colt = (pn - 22) * 256; }
        else if (pn < 30) { kind = 0; base = IR;  ldc = 1024; colt = (pn - 26) * 256; }
        else if (pn < 34) { kind = 1; base = GR;  ldc = 1024; colt = (pn - 30) * 256; }
        else if (pn < 42) { kind = 2; base = SA;  ldc = 2048; colt = (pn - 34) * 256; }
        else              { kind = 2; base = SB;  ldc = 2048; colt = (pn - 42) * 256; }
        const int col0 = colt + wc * 64 + 16 * fq;
        if (kind == 3) {
            f32x4 lb[4];
#pragma unroll
            for (int q = 0; q < 4; ++q) { const f32x4 l0 = *(const f32x4*)(lbl + col0 + 4 * q), l1 = *(const f32x4*)(lbl + 1024 + col0 + 4 * q);
#pragma unroll
                for (int j = 0; j < 4; ++j) lb[q][j] = sigmoidf_(l0[j] - l1[j]); }
            EPI_ROWS_BEGIN
                bf16* rowp = LF + row * 1024 + col0; f32x4 o[4];
#pragma unroll
                for (int q = 0; q < 4; ++q) { const f32x4 v = EPI_V4(q);
#pragma unroll
                    for (int j = 0; j < 4; ++j) { const float l = lb[q][j]; o[q][j] = __logf(l + (1.f - l) * sigmoidf_(v[j])); } }
                *(u32x4*)rowp = pack8(o[0], o[1]); *(u32x4*)(rowp + 8) = pack8(o[2], o[3]);
            EPI_ROWS_END
        } else {
            EPI_ROWS_BEGIN
                bf16* rowp = base + row * ldc + col0;
#pragma unroll
                for (int hq = 0; hq < 2; ++hq) { f32x4 v0 = EPI_V4(2 * hq), v1 = EPI_V4(2 * hq + 1);
                    if (kind == 1) {
#pragma unroll
                        for (int j = 0; j < 4; ++j) { v0[j] = siluf_(v0[j]); v1[j] = siluf_(v1[j]); } }
                    if (kind == 2) {
#pragma unroll
                        for (int j = 0; j < 4; ++j) { v0[j] = sigmoidf_(v0[j]); v1[j] = sigmoidf_(v1[j]); } }
                    *(u32x4*)(rowp + 8 * hq) = pack8(v0, v1); }
            EPI_ROWS_END
        }
    }
};
struct EpiGate {
    static constexpr int MID_T = 0;
    unsigned char* SA; unsigned char* SB;
    __device__ __forceinline__ void operator()(const f32x4 (&acc)[2][2][4][2], const Unit& u, int wr, int wc, int fr, int fq) const {
        unsigned char* base = u.pn < 8 ? SA : SB; const int col0 = (u.pn & 7) * 256 + wc * 64 + 16 * fq;
        EPI_ROWS_BEGIN
            u32x4 o;
#pragma unroll
            for (int q = 0; q < 4; ++q) { f32x4 v = EPI_V4(q);
#pragma unroll
                for (int j = 0; j < 4; ++j) v[j] = sigmoidf_(v[j]);
                o[q] = pk4_gate(v); }
            *(u32x4*)(base + row * D + col0) = o;
        EPI_ROWS_END
    }
};
struct EpiMerged {
    static constexpr int MID_T = 8;
    const unsigned char* SA; const unsigned char* SB; unsigned char* MG;
    __device__ __forceinline__ void mid(f32x4 (&acc)[2][2][4][2], const Unit& u, int wr, int wc, int fr, int fq) const {
        const unsigned base = (unsigned)(u.row0 + wr * 64 + fr) * D + (unsigned)(u.pn * 256 + wc * 64 + 16 * fq);
        const char* sa = (const char*)SA; const char* sb = (const char*)SB;
#pragma unroll
        for (int ai = 0; ai < 2; ++ai)
#pragma unroll
            for (int m = 0; m < 4; ++m) {
                const unsigned off = base + (unsigned)((ai * HALF + m * 16) * D); const u32x4 ga = *(const u32x4*)(sa + off), gb = *(const u32x4*)(sb + off);
#pragma unroll
                for (int q = 0; q < 4; ++q) { const f32x4 fa = up4_gate(ga[q]), fb = up4_gate(gb[q]); f32x4& v = acc[ai][q >> 1][m][q & 1];
#pragma unroll
                    for (int j = 0; j < 4; ++j) v[j] *= fa[j] * __builtin_amdgcn_rcpf(fb[j]); }
                if (m & 1) asm volatile("" ::: "memory");
            }
    }
    __device__ __forceinline__ void operator()(const f32x4 (&acc)[2][2][4][2], const Unit& u, int wr, int wc, int fr, int fq) const {
        const int col0 = u.pn * 256 + wc * 64 + 16 * fq;
        EPI_ROWS_BEGIN
            const u32x4 g = *(const u32x4*)(SB + row * D + col0); u32x4 o;
#pragma unroll
            for (int q = 0; q < 4; ++q) { const f32x4 fb = up4_gate(g[q]); f32x4 v = EPI_V4(q);
#pragma unroll
                for (int j = 0; j < 4; ++j) v[j] *= fb[j] * (SC_M / 255.f);
                o[q] = pk4_fp8(v[0], v[1], v[2], v[3]); }
            *(u32x4*)(MG + row * D + col0) = o;
        EPI_ROWS_END
    }
};
struct EpiF32 {
    static constexpr int MID_T = 0;
    bf16* Y;
    __device__ __forceinline__ void operator()(const f32x4 (&acc)[2][2][4][2], const Unit& u, int wr, int wc, int fr, int fq) const {
        const int col0 = u.pn * 256 + wc * 64 + 16 * fq;
        EPI_ROWS_BEGIN
            bf16* p = Y + row * D + col0;
            *(u32x4*)p = pack8(EPI_V4(0), EPI_V4(1)); *(u32x4*)(p + 8) = pack8(EPI_V4(2), EPI_V4(3));
        EPI_ROWS_END
    }
};
struct EpiRouter {
    static constexpr int MID_T = 0;
    float* RL;
    __device__ __forceinline__ void operator()(const f32x4 (&acc)[2][2][4][2], const Unit& u, int wr, int wc, int fr, int fq) const {
        if (wc == 0) {
            EPI_ROWS_BEGIN
                float* p = RL + ((size_t)u.e * T + row) * 64 + 16 * fq;
#pragma unroll
                for (int q = 0; q < 4; ++q) *(f32x4*)(p + 4 * q) = EPI_V4(q);
            EPI_ROWS_END
        }
    }
};
struct EpiSwiglu {
    static constexpr int MID_T = 0;
    unsigned char* HID;
    __device__ __forceinline__ void operator()(const f32x4 (&acc)[2][2][4][2], const Unit& u, int wr, int wc, int fr, int fq) const {
        const int col0 = u.pn * 128 + wc * 32 + 8 * fq;
        EPI_ROWS_BEGIN
            if (rt < u.nvalid) { f32x4 v0, v1;
#pragma unroll
                for (int j = 0; j < 4; ++j) { v0[j] = siluf_(acc[ai][0][m][0][j]) * acc[ai][1][m][0][j]; v1[j] = siluf_(acc[ai][0][m][1][j]) * acc[ai][1][m][1][j]; }
                u32x2 w; w.x = pk4_fp8(v0[0], v0[1], v0[2], v0[3]); w.y = pk4_fp8(v1[0], v1[1], v1[2], v1[3]);
                *(u32x2*)(HID + row * DE + col0) = w; }
        EPI_ROWS_END
    }
};
struct EpiDown {
    static constexpr int MID_T = 0;
    unsigned char* YS;
    __device__ __forceinline__ void operator()(const f32x4 (&acc)[2][2][4][2], const Unit& u, int wr, int wc, int fr, int fq) const {
        const int col0 = u.pn * 256 + wc * 64 + 16 * fq;
        EPI_ROWS_BEGIN
            if (rt < u.nvalid) { u32x4 o;
                { const f32x4 v = EPI_V4(0); o.x = pk4_fp8(v[0], v[1], v[2], v[3]); } { const f32x4 v = EPI_V4(1); o.y = pk4_fp8(v[0], v[1], v[2], v[3]); }
                { const f32x4 v = EPI_V4(2); o.z = pk4_fp8(v[0], v[1], v[2], v[3]); } { const f32x4 v = EPI_V4(3); o.w = pk4_fp8(v[0], v[1], v[2], v[3]); }
                *(u32x4*)(YS + row * D + col0) = o; }
        EPI_ROWS_END
    }
};
}

struct Args { const float* in[22]; float* out; unsigned char* ws; int ph_lo, ph_hi; };
enum { I_X = 0, I_C, I_WADA, I_BADA, I_PRE_MIX, I_POST_MIX, I_WIN, I_LBL, I_HNORM, I_WBA, I_WBH, I_WOUT, I_PRE_FFN, I_POST_FFN, I_WR, I_RBIAS, I_WGE, I_WUE, I_WDE, I_WGS, I_WUS, I_WDS };

template <bool F8>
__device__ __forceinline__ void p0_item64(const float* W, int Kmat, int N, unsigned char* WT, size_t dst_estride, int mode, float scale, LAS unsigned char* scr, int item, int lane) {
    const int nblk = N / 64, kb = item / nblk, nb = item % nblk, kpm = Kmat / 64, e = kb / kpm, k0 = 64 * (kb % kpm), n0 = 64 * nb;
    const float* src = W + ((size_t)e * Kmat + k0) * N + n0 + 4 * (lane & 15);
    const int r16 = lane & 15, g = lane >> 4, q4 = (lane & 15) >> 2, p4 = lane & 3;
    f32x4 v[16];
#pragma unroll
    for (int i = 0; i < 16; ++i) v[i] = __builtin_nontemporal_load((const f32x4*)(src + (size_t)(4 * i + g) * N));
#pragma unroll
    for (int i = 0; i < 16; ++i) { u32x2 w; w.x = cvt_pk_bf16(v[i][0] * scale, v[i][1] * scale); w.y = cvt_pk_bf16(v[i][2] * scale, v[i][3] * scale);
        *(LAS u32x2*)(scr + (4 * i + g) * 144 + r16 * 8) = w; }
    constexpr int ESZ = F8 ? 1 : 2;
#pragma unroll
    for (int c = 0; c < 4; ++c) {
        const int n = n0 + 16 * c + r16; int dr = n; if (mode) dr = 256 * (n >> 7) + 16 * ((n & 127) >> 3) + (n & 7) + (mode == 2 ? 8 : 0);
        unsigned char* drow = WT + (size_t)e * dst_estride + ((size_t)dr * Kmat + k0) * ESZ;
        if constexpr (F8) {
            unsigned o[4];
#pragma unroll
            for (int t = 0; t < 4; ++t) { const s16x4 r = tr_read4(scr + (16 * g + 4 * t + q4) * 144 + (16 * c + 4 * p4) * 2);
                o[t] = pk4_fp8(bf2f((unsigned short)r[0]), bf2f((unsigned short)r[1]), bf2f((unsigned short)r[2]), bf2f((unsigned short)r[3])); }
            *(u32x4*)(drow + 16 * g) = (u32x4){o[0], o[1], o[2], o[3]};
        } else {
#pragma unroll
            for (int ks = 0; ks < 2; ++ks) { const s16x4 lo = tr_read4(scr + (32 * ks + 8 * g + q4) * 144 + (16 * c + 4 * p4) * 2), hi = tr_read4(scr + (32 * ks + 8 * g + 4 + q4) * 144 + (16 * c + 4 * p4) * 2);
                *(bf16x8*)(drow + (32 * ks + 8 * g) * 2) = __builtin_shufflevector(lo, hi, 0, 1, 2, 3, 4, 5, 6, 7); }
        }
    }
}
__device__ __forceinline__ void phase0(const Args& a, LAS unsigned char* lds, int tid, int lane, int wave, int G) {
    unsigned char* ws = a.ws;
    {
        LAS float* red = (LAS float*)lds;
        const float* c = a.in[I_C]; const float* wada = a.in[I_WADA];
        float* modp = (float*)(ws + WS_MODP);
        for (int item = blockIdx.x; item < 256; item += G) {
            const int ks = item >> 4, ns = item & 15;
            f32x4 acc[4][3];
#pragma unroll
            for (int b = 0; b < 4; ++b)
#pragma unroll
                for (int j = 0; j < 3; ++j) acc[b][j] = (f32x4){0.f, 0.f, 0.f, 0.f};
#pragma unroll 4
            for (int kk = 0; kk < 16; ++kk) {
                const int k = ks * 128 + wave * 16 + kk;
                float s[4];
#pragma unroll
                for (int b = 0; b < 4; ++b) { const float cv = c[b * D + k]; s[b] = cv / (1.f + __expf(-cv)); }
                const f32x4* wrow = (const f32x4*)(wada + (size_t)k * 12288 + ns * 768);
#pragma unroll
                for (int j = 0; j < 3; ++j) { const f32x4 w = wrow[lane + 64 * j];
#pragma unroll
                    for (int b = 0; b < 4; ++b) acc[b][j] += w * s[b]; }
            }
#pragma unroll
            for (int b = 0; b < 4; ++b)
#pragma unroll
                for (int j = 0; j < 3; ++j) *(LAS f32x4*)(red + (wave * 4 + b) * 768 + 4 * (lane + 64 * j)) = acc[b][j];
            __syncthreads();
            for (int o = tid; o < 4 * 768; o += 512) { const int b = o / 768, n = o % 768; float s = 0.f;
#pragma unroll
                for (int w = 0; w < 8; ++w) s += red[(w * 4 + b) * 768 + n];
                modp[((size_t)ks * 4 + b) * 12288 + ns * 768 + n] = s; }
            __syncthreads();
        }
    }
    {
        u32x4* z = (u32x4*)(ws + WS_WR + (size_t)64 * 2048 * 2); const int nz = 192 * 2048 * 2 / 16;
        for (int i = blockIdx.x * 512 + tid; i < nz; i += G * 512) z[i] = (u32x4){0u, 0u, 0u, 0u};
    }
    __syncthreads();
    LAS unsigned char* scr = lds + wave * 9216;
    const int gw = blockIdx.x * 8 + wave, NGW = G * 8;
    for (int it = gw; it < 32 * 200; it += NGW) {
        if (it % 200 < 72) p0_item64<true>(a.in[I_WIN], 2048, INC, ws + WS_ARENA + A_WTIN, 0, 0, SC_GU, scr, it, lane);
        else if (it % 200 < 136) p0_item64<false>(a.in[I_WIN], 2048, INC, ws + WS_ARENA + A_WTIN, 0, 0, 1.f, scr, it, lane);
        else p0_item64<true>(a.in[I_WIN], 2048, INC, ws + WS_ARENA + A_WG8 - (size_t)8704 * 2048, 0, 0, SC_GU, scr, it, lane); }
}
struct ConvDesc { const float* W; unsigned char* WT; size_t estride; int Kmat, N, mode, f8; float scale; int item; int ldd; };
__device__ __forceinline__ bool conv_desc(const Args& a, unsigned it, ConvDesc& d) {
    constexpr int I_BA = 8 * 32, I_BH = 16 * 32, I_OUT = 32 * 32, I_R = 32 * 1, I_GE = 64 * 32 * 8, I_DE = 64 * 8 * 32, I_GS = 32 * 8, I_DS = 8 * 32;
    constexpr unsigned NIT = I_BA + I_BH + I_OUT + I_R + 2 * I_GE + I_DE + 2 * I_GS + I_DS;
    if (it >= NIT) return false;
    unsigned char* ws = a.ws; unsigned char* wgu = ws + WS_WGU; unsigned char* wd = ws + WS_WD; unsigned char* ar = ws + WS_ARENA;
    int r = (int)it;
    if (r < I_BA) { d = ConvDesc{a.in[I_WBA], ar + A_WBA, 0, 512, 2048, 0, 0, 1.f, r, 1536}; return true; } r -= I_BA;
    if (r < I_BH) { d = ConvDesc{a.in[I_WBH], ar + A_WBA + 512 * 2, 0, 1024, 2048, 0, 0, 1.f, r, 1536}; return true; } r -= I_BH;
    if (r < I_OUT) { d = ConvDesc{a.in[I_WOUT], ar + A_WOUT, 0, 2048, 2048, 0, 1, SC_GU, r, 2048}; return true; } r -= I_OUT;
    if (r < I_R) { d = ConvDesc{a.in[I_WR], ws + WS_WR, 0, 2048, 64, 0, 0, 1.f, r, 2048}; return true; } r -= I_R;
    if (r < I_GE) { d = ConvDesc{a.in[I_WGE], wgu, (size_t)1024 * 2048, 2048, 512, 1, 1, SC_GU, r, 2048}; return true; } r -= I_GE;
    if (r < I_GE) { d = ConvDesc{a.in[I_WUE], wgu, (size_t)1024 * 2048, 2048, 512, 2, 1, SC_GU, r, 2048}; return true; } r -= I_GE;
    if (r < I_DE) { d = ConvDesc{a.in[I_WDE], wd, (size_t)2048 * 512, 512, 2048, 0, 1, SC_D, r, 512}; return true; } r -= I_DE;
    if (r < I_GS) { d = ConvDesc{a.in[I_WGS], wgu + (size_t)64 * 1024 * 2048, 0, 2048, 512, 1, 1, SC_GU, r, 2048}; return true; } r -= I_GS;
    if (r < I_GS) { d = ConvDesc{a.in[I_WUS], wgu + (size_t)64 * 1024 * 2048, 0, 2048, 512, 2, 1, SC_GU, r, 2048}; return true; } r -= I_GS;
    d = ConvDesc{a.in[I_WDS], wd + (size_t)64 * 2048 * 512, 0, 512, 2048, 0, 1, SC_D, r, 512}; return true;
}
__device__ __forceinline__ void conv_load(const ConvDesc& d, int lane, f32x4 (&v)[16]) {
    const int nblk = d.N / 64, kb = d.item / nblk, nb = d.item % nblk, kpm = d.Kmat / 64, e = kb / kpm, k0 = 64 * (kb % kpm), n0 = 64 * nb;
    const float* src = d.W + ((size_t)e * d.Kmat + k0) * d.N + n0 + 4 * (lane & 15);
#pragma unroll
    for (int i = 0; i < 16; ++i) v[i] = __builtin_nontemporal_load((const f32x4*)(src + (size_t)(4 * i + (lane >> 4)) * d.N));
}
__device__ __forceinline__ void conv_finish(const ConvDesc& d, int lane, const f32x4 (&v)[16], LAS unsigned char* scr) {
    const int nblk = d.N / 64, kb = d.item / nblk, nb = d.item % nblk, kpm = d.Kmat / 64, e = kb / kpm, k0 = 64 * (kb % kpm), n0 = 64 * nb;
    const int r16 = lane & 15, g = lane >> 4, q4 = (lane & 15) >> 2, p4 = lane & 3; const float scale = d.scale;
#pragma unroll
    for (int i = 0; i < 16; ++i) { u32x2 w; w.x = cvt_pk_bf16(v[i][0] * scale, v[i][1] * scale); w.y = cvt_pk_bf16(v[i][2] * scale, v[i][3] * scale);
        *(LAS u32x2*)(scr + (4 * i + g) * 144 + r16 * 8) = w; }
#pragma unroll
    for (int c = 0; c < 4; ++c) {
        const int n = n0 + 16 * c + r16; int dr = n; if (d.mode) dr = 256 * (n >> 7) + 16 * ((n & 127) >> 3) + (n & 7) + (d.mode == 2 ? 8 : 0);
        if (d.f8) {
            unsigned char* drow = d.WT + (size_t)e * d.estride + ((size_t)dr * d.ldd + k0);
            unsigned o[4];
#pragma unroll
            for (int t = 0; t < 4; ++t) { const s16x4 r = tr_read4(scr + (16 * g + 4 * t + q4) * 144 + (16 * c + 4 * p4) * 2);
                o[t] = pk4_fp8(bf2f((unsigned short)r[0]), bf2f((unsigned short)r[1]), bf2f((unsigned short)r[2]), bf2f((unsigned short)r[3])); }
            *(u32x4*)(drow + 16 * g) = (u32x4){o[0], o[1], o[2], o[3]};
        } else {
            unsigned char* drow = d.WT + (size_t)e * d.estride + ((size_t)dr * d.ldd + k0) * 2;
#pragma unroll
            for (int ks = 0; ks < 2; ++ks) { const s16x4 lo = tr_read4(scr + (32 * ks + 8 * g + q4) * 144 + (16 * c + 4 * p4) * 2), hi = tr_read4(scr + (32 * ks + 8 * g + 4 + q4) * 144 + (16 * c + 4 * p4) * 2);
                *(bf16x8*)(drow + (32 * ks + 8 * g) * 2) = __builtin_shufflevector(lo, hi, 0, 1, 2, 3, 4, 5, 6, 7); }
        }
    }
}
constexpr unsigned CHW = 32;
__device__ __forceinline__ unsigned conv_ticket(unsigned* q, volatile LAS unsigned* cw, int lane) {
    LAS unsigned long long* S = (LAS unsigned long long*)(cw); LAS unsigned* NXT = (LAS unsigned*)(cw + 2);
    for (;;) {
        unsigned long long old = 0ull; if (lane == 0) old = __hip_atomic_fetch_add(S, 1ull, __ATOMIC_RELAXED, __HIP_MEMORY_SCOPE_WORKGROUP);
        const unsigned taken = (unsigned)__builtin_amdgcn_readfirstlane((int)(unsigned)old), base = (unsigned)__builtin_amdgcn_readfirstlane((int)(unsigned)(old >> 32));
        if (taken < CHW) {
            if (taken == CHW / 2 && lane == 0) { const unsigned b = atomicAdd(q, CHW); __hip_atomic_store(NXT, b + 1u, __ATOMIC_RELAXED, __HIP_MEMORY_SCOPE_WORKGROUP); }
            return base + taken;
        }
        if (taken == CHW) {
            if (lane == 0) {
                unsigned nb;
                if (base == 0xFFFFFFFFu) nb = atomicAdd(q, CHW);
                else { unsigned v; while ((v = __hip_atomic_load(NXT, __ATOMIC_RELAXED, __HIP_MEMORY_SCOPE_WORKGROUP)) == 0u) __builtin_amdgcn_s_sleep(1); nb = v - 1u; __hip_atomic_store(NXT, 0u, __ATOMIC_RELAXED, __HIP_MEMORY_SCOPE_WORKGROUP); }
                (void)__hip_atomic_exchange(S, (unsigned long long)nb << 32, __ATOMIC_RELAXED, __HIP_MEMORY_SCOPE_WORKGROUP);
            }
        } else {
            if (lane == 0) { while ((unsigned)(__hip_atomic_load(S, __ATOMIC_RELAXED, __HIP_MEMORY_SCOPE_WORKGROUP) >> 32) == base) __builtin_amdgcn_s_sleep(1); }
        }
    }
}
__device__ __forceinline__ void conv_queue(const Args& a, LAS unsigned char* lds, int lane, int wave, volatile LAS unsigned* cw) {
    unsigned* q = (unsigned*)(a.ws + WS_CTL) + CW_Q;
    LAS unsigned char* scr = lds + wave * 9216;
    ConvDesc dc, dn; f32x4 va[16], vb[16];
    bool have = conv_desc(a, conv_ticket(q, cw, lane), dc);
    if (have) conv_load(dc, lane, va);
    while (have) {
        const bool hn = conv_desc(a, conv_ticket(q, cw, lane), dn);
        if (hn) conv_load(dn, lane, vb);
        conv_finish(dc, lane, va, scr);
        if (!hn) break;
        have = conv_desc(a, conv_ticket(q, cw, lane), dc);
        if (have) conv_load(dc, lane, va);
        conv_finish(dn, lane, vb, scr);
    }
}

__device__ __forceinline__ void conv_queue_until(const Args& a, LAS unsigned char* lds, int lane, int wave, volatile LAS unsigned* cw, unsigned* done_word, unsigned need) {
    unsigned* q = (unsigned*)(a.ws + WS_CTL) + CW_Q;
    LAS unsigned char* scr = lds + wave * 9216;
    for (;;) {
        unsigned dn_ = 0u;
        if (lane == 0) { dn_ = __hip_atomic_load(done_word, __ATOMIC_RELAXED, __HIP_MEMORY_SCOPE_AGENT); }
        if ((unsigned)__builtin_amdgcn_readfirstlane((int)dn_) >= need) break;
        const unsigned it0 = conv_ticket(q, cw, lane), it1 = conv_ticket(q, cw, lane);
        ConvDesc d0, d1; f32x4 v0[16], v1[16];
        const bool h0 = conv_desc(a, it0, d0), h1 = conv_desc(a, it1, d1);
        if (!h0 && !h1) break;
        if (h0) conv_load(d0, lane, v0); if (h1) conv_load(d1, lane, v1);
        if (h0) conv_finish(d0, lane, v0, scr); if (h1) conv_finish(d1, lane, v1, scr);
    }
}

__device__ __forceinline__ void phase1(const Args& a, int tid, int G) {
    const float* modp = (const float*)(a.ws + WS_MODP); float* modf = (float*)(a.ws + WS_MODF); const float* bada = a.in[I_BADA];
    for (int o = blockIdx.x * 512 + tid; o < 4 * 12288; o += G * 512) { float s = 0.f;
#pragma unroll
        for (int k = 0; k < 16; ++k) s += modp[(size_t)k * 4 * 12288 + o];
        modf[o] = s + bada[o % 12288]; }
}

__device__ __forceinline__ void phase2(const Args& a, int lane, int wave, int G) {
    const float* x = a.in[I_X]; const float* g1 = a.in[I_PRE_MIX]; const float* modf = (const float*)(a.ws + WS_MODF);
    bf16* H = (bf16*)(a.ws + WS_ARENA + A_H); unsigned char* H8 = a.ws + WS_ARENA + A_H8;
    const int gw = blockIdx.x * 8 + wave, NGW = G * 8;
    for (int m = gw; m < T; m += NGW) {
        const int b = m / SEQ; const f32x4* xr = (const f32x4*)(x + (size_t)m * D) + lane;
        f32x4 v[8]; float ss = 0.f;
#pragma unroll
        for (int j = 0; j < 8; ++j) { v[j] = xr[64 * j]; ss += (v[j][0] * v[j][0] + v[j][1] * v[j][1]) + (v[j][2] * v[j][2] + v[j][3] * v[j][3]); }
        const float rstd = rsqrtf(wave_sum(ss) * (1.f / D) + EPS);
        const float* mb = modf + (size_t)b * 12288;
        u32x2* o = (u32x2*)(H + (size_t)m * D) + lane;
#pragma unroll
        for (int j = 0; j < 8; ++j) { const int cidx = 4 * lane + 256 * j; const f32x4 g = *(const f32x4*)(g1 + cidx), sh = *(const f32x4*)(mb + cidx), sc = *(const f32x4*)(mb + 2048 + cidx);
            f32x4 h;
#pragma unroll
            for (int q = 0; q < 4; ++q) h[q] = v[j][q] * rstd * g[q] * (1.f + sc[q]) + sh[q];
            u32x2 w; w.x = cvt_pk_bf16(h[0], h[1]); w.y = cvt_pk_bf16(h[2], h[3]); o[64 * j] = w;
            *(unsigned*)(H8 + (size_t)m * D + cidx) = pk4_fp8(h[0], h[1], h[2], h[3]); }
    }
}

__device__ __forceinline__ bf16x8 tr_pair(const LAS unsigned char* p0, const LAS unsigned char* p1) {
    const s16x4 lo = __builtin_amdgcn_ds_read_tr16_b64_v4i16((LAS s16x4*)p0);
    const s16x4 hi = __builtin_amdgcn_ds_read_tr16_b64_v4i16((LAS s16x4*)p1);
    return __builtin_shufflevector(lo, hi, 0, 1, 2, 3, 4, 5, 6, 7);
}
__device__ __forceinline__ bf16x8 pack_bf8(const f32x4 a0, const f32x4 a1) { u32x4 w; w.x = cvt_pk_bf16(a0[0], a0[1]); w.y = cvt_pk_bf16(a0[2], a0[3]); w.z = cvt_pk_bf16(a1[0], a1[1]); w.w = cvt_pk_bf16(a1[2], a1[3]); return __builtin_bit_cast(bf16x8, w); }
constexpr int AT_KS = 272, AT_VS = 288, AT_VOFF = 256 * AT_KS;
constexpr float LOG2E = 1.4426950408889634f, LN2 = 0.6931471805599453f;
__device__ __forceinline__ void phase4_attn(const Args& a, LAS unsigned char* lds, int tid, int lane, int wave, int G) {
    const bf16* QKV = (const bf16*)(a.ws + WS_ARENA + A_QKV); bf16* O12 = (bf16*)(a.ws + WS_ARENA + A_O12); float* LSE = (float*)(a.ws + WS_ARENA + A_LSE);
    LAS unsigned char* Kl = lds; LAS unsigned char* Vl = lds + AT_VOFF;
    const int r16 = lane & 15, g = lane >> 4, q4 = (lane & 15) >> 2, p4 = lane & 3;
    __syncthreads();
    for (int u = tid; u < 16 * AT_VS / 4; u += 512) ((LAS unsigned*)(Vl + 256 * AT_VS))[u] = 0u;
    for (int item = blockIdx.x; item < 1536; item += G) {
        const int rn = item & 31, bh = item >> 5, h = bh % 12, b = bh / 12, grp = h >> 2;
        const int dil = grp == 0 ? 1 : (grp == 1 ? 4 : 16), nb = 32 / dil, r = rn / nb, n = rn % nb;
        const size_t rstride = (size_t)dil * 4608;
        const bf16* base = QKV + ((size_t)b * SEQ + r) * 4608 + h * 128;
        __syncthreads();
#pragma unroll
        for (int i = 0; i < 8; ++i) { const int row = (tid >> 4) + 32 * i, c16 = tid & 15; const int l = 128 * (n - 1) + row;
            u32x4 kv = (u32x4){0u, 0u, 0u, 0u}, vv = (u32x4){0u, 0u, 0u, 0u};
            if (l >= 0) { const bf16* p = base + (size_t)l * rstride + c16 * 8; kv = *(const u32x4*)(p + 1536); vv = *(const u32x4*)(p + 3072); }
            *(LAS u32x4*)(Kl + row * AT_KS + c16 * 16) = kv; *(LAS u32x4*)(Vl + row * AT_VS + c16 * 16) = vv; }
        const int lq = 128 * n + 16 * wave + r16;
        bf16x8 qf[4];
#pragma unroll
        for (int kk = 0; kk < 4; ++kk) qf[kk] = *(const bf16x8*)(base + (size_t)lq * rstride + 32 * kk + 8 * g);
        __syncthreads();
        f32x4 s[9];
#pragma unroll
        for (int kt = 0; kt < 9; ++kt) { s[kt] = (f32x4){0.f, 0.f, 0.f, 0.f};
#pragma unroll
            for (int kk = 0; kk < 4; ++kk) { const bf16x8 kf = *(const LAS bf16x8*)(Kl + (16 * (wave + kt) + r16) * AT_KS + (32 * kk + 8 * g) * 2);
                s[kt] = __builtin_amdgcn_mfma_f32_16x16x32_bf16(kf, qf[kk], s[kt], 0, 0, 0); } }
        const float slope2 = exp2f(-8.0f * (float)(h + 1) / 12.0f) * (float)dil * LOG2E, c1 = 0.08838834764831845f * LOG2E;
        float mx = -INFINITY;
#pragma unroll
        for (int kt = 0; kt < 9; ++kt)
#pragma unroll
            for (int i = 0; i < 4; ++i) { const int jj = 128 + r16 - 16 * kt - 4 * g - i, ki = 16 * (wave + kt) + 4 * g + i;
                const bool valid = (jj >= 0) && (jj <= 128) && (n > 0 || ki >= 128);
                const float v = valid ? s[kt][i] * c1 - slope2 * (float)jj : -INFINITY; s[kt][i] = v; mx = fmaxf(mx, v); }
        mx = fmaxf(mx, __shfl_xor(mx, 16)); mx = fmaxf(mx, __shfl_xor(mx, 32));
        float sum = 0.f;
#pragma unroll
        for (int kt = 0; kt < 9; ++kt)
#pragma unroll
            for (int i = 0; i < 4; ++i) { const float p = __builtin_amdgcn_exp2f(s[kt][i] - mx); s[kt][i] = p; sum += p; }
        sum += __shfl_xor(sum, 16); sum += __shfl_xor(sum, 32);
        bf16x8 pf[5];
#pragma unroll
        for (int pp = 0; pp < 5; ++pp) pf[pp] = pack_bf8(s[2 * pp], (2 * pp + 1 < 9) ? s[(2 * pp + 1 < 9) ? 2 * pp + 1 : 8] : (f32x4){0.f, 0.f, 0.f, 0.f});
        const float inv = 1.f / sum;
        const size_t mq = (size_t)b * SEQ + (size_t)lq * dil + r;
#pragma unroll
        for (int dt = 0; dt < 8; ++dt) { f32x4 o = (f32x4){0.f, 0.f, 0.f, 0.f};
#pragma unroll
            for (int pp = 0; pp < 5; ++pp) { const int r0 = 16 * (wave + 2 * pp) + 4 * g + q4;
                const bf16x8 vf = tr_pair(Vl + r0 * AT_VS + (16 * dt + 4 * p4) * 2, Vl + (r0 + 16) * AT_VS + (16 * dt + 4 * p4) * 2);
                o = __builtin_amdgcn_mfma_f32_16x16x32_bf16(vf, pf[pp], o, 0, 0, 0); }
            u32x2 w; w.x = cvt_pk_bf16(o[0] * inv, o[1] * inv); w.y = cvt_pk_bf16(o[2] * inv, o[3] * inv);
            *(u32x2*)(O12 + mq * ATT_W + h * 128 + 16 * dt + 4 * g) = w; }
        if (g == 0) LSE[mq * 12 + h] = (mx + __log2f(sum)) * LN2;
    }
}

constexpr int HL_PT = 0, HL_BR = 4096, HL_NR = 5120, HL_QT = 8192, HL_KT = HL_QT + 64 * 272, HL_QE = HL_KT + 64 * 272, HL_VV = HL_QE + 64 * 272, HL_SS = HL_VV + 64 * 288, HL_KH = HL_QT;
static_assert(HL_SS + 128 * 288 <= MISC_OFF, "HGRN LDS map");
__device__ __forceinline__ void hgrn_load_cumsum(const bf16* LF, size_t m0, int h, LAS unsigned char* lds, int tid, float (&gl)[8][2], float (&bc)[8][2]) {
    const int kp = tid & 63, part = tid >> 6; LAS float* PT = (LAS float*)(lds + HL_PT);
    float run0 = 0.f, run1 = 0.f;
#pragma unroll
    for (int i = 0; i < 8; ++i) { const unsigned gw_ = *(const unsigned*)(LF + (m0 + 8 * part + i) * HW + h * 128 + 2 * kp); const f32x2 gv = {bflo(gw_), bfhi(gw_)}; gl[i][0] = gv.x; gl[i][1] = gv.y; run0 += gv.x; run1 += gv.y; bc[i][0] = run0; bc[i][1] = run1; }
    *(LAS f32x2*)(PT + part * 128 + 2 * kp) = (f32x2){run0, run1};
    __syncthreads();
    float off0 = 0.f, off1 = 0.f;
    for (int p = 0; p < part; ++p) { const f32x2 t = *(const LAS f32x2*)(PT + p * 128 + 2 * kp); off0 += t.x; off1 += t.y; }
#pragma unroll
    for (int i = 0; i < 8; ++i) { bc[i][0] += off0; bc[i][1] += off1; }
}
__device__ __forceinline__ void phase4_hgrn(const Args& a, LAS unsigned char* lds, int tid, int lane, int wave, int G) {
    const bf16* IR = (const bf16*)(a.ws + WS_ARENA + A_IR); const bf16* LF = (const bf16*)(a.ws + WS_ARENA + A_LF);
    bf16* SU = (bf16*)a.out; float* DEC = (float*)(a.ws + WS_ARENA + A_DEC);
    const int r16 = lane & 15, g = lane >> 4, q4 = (lane & 15) >> 2, p4 = lane & 3, kp = tid & 63, part = tid >> 6;
    LAS float* BR = (LAS float*)(lds + HL_BR); LAS unsigned char* KH = lds + HL_KH; LAS unsigned char* VV = lds + HL_VV;
    for (int item = blockIdx.x; item < 2048; item += G) {
        const int b = item >> 9, h = (item >> 6) & 7, c = item & 63; const size_t m0 = (size_t)b * SEQ + 64 * c;
        __syncthreads();
#pragma unroll
        for (int i = 0; i < 2; ++i) { const int ch = tid + 512 * i, row = ch >> 4, c16 = ch & 15; *(LAS u32x4*)(VV + row * 288 + c16 * 16) = *(const u32x4*)(IR + (m0 + row) * HW + h * 128 + c16 * 8); }
        float gl[8][2], bc[8][2];
        hgrn_load_cumsum(LF, m0, h, lds, tid, gl, bc);
        if (part == 7) *(LAS f32x2*)(BR + 128 + 2 * kp) = (f32x2){bc[7][0], bc[7][1]};
        __syncthreads();
        const f32x2 bl = *(const LAS f32x2*)(BR + 128 + 2 * kp);
#pragma unroll
        for (int i = 0; i < 8; ++i) { const float k0 = (1.f - __expf(gl[i][0])) * __expf(bl.x - bc[i][0]), k1 = (1.f - __expf(gl[i][1])) * __expf(bl.y - bc[i][1]);
            *(LAS unsigned*)(KH + (8 * part + i) * 288 + kp * 4) = cvt_pk_bf16(k0, k1); }
        if (part == 7) *(f32x2*)(DEC + (size_t)item * 128 + 2 * kp) = (f32x2){__expf(bl.x), __expf(bl.y)};
        __syncthreads();
        f32x4 acc[8];
#pragma unroll
        for (int kt = 0; kt < 8; ++kt) acc[kt] = (f32x4){0.f, 0.f, 0.f, 0.f};
#pragma unroll
        for (int ss = 0; ss < 2; ++ss) { const int r0 = 32 * ss + 8 * g + q4;
            const bf16x8 af = tr_pair(VV + r0 * 288 + (16 * wave + 4 * p4) * 2, VV + (r0 + 4) * 288 + (16 * wave + 4 * p4) * 2);
#pragma unroll
            for (int kt = 0; kt < 8; ++kt) { const bf16x8 bf = tr_pair(KH + r0 * 288 + (16 * kt + 4 * p4) * 2, KH + (r0 + 4) * 288 + (16 * kt + 4 * p4) * 2);
                acc[kt] = __builtin_amdgcn_mfma_f32_16x16x32_bf16(af, bf, acc[kt], 0, 0, 0); } }
#pragma unroll
        for (int kt = 0; kt < 8; ++kt) { u32x2 w; w.x = cvt_pk_bf16(acc[kt][0], acc[kt][1]); w.y = cvt_pk_bf16(acc[kt][2], acc[kt][3]);
            *(u32x2*)(SU + ((size_t)item * 128 + 16 * kt + r16) * 128 + 16 * wave + 4 * g) = w; }
    }
}
__device__ __forceinline__ void phase5_scan(const Args& a, int tid, int G) {
    const bf16* U = (const bf16*)a.out; bf16* Sb = (bf16*)a.out + (size_t)2048 * 128 * 128; const float* DEC = (const float*)(a.ws + WS_ARENA + A_DEC);
    for (int gid = blockIdx.x * 512 + tid; gid < 32 * 4096; gid += G * 512) {
        const int bh = gid >> 12, e4 = gid & 4095, k = e4 >> 5, v4 = (e4 & 31) * 4;
        float S0 = 0.f, S1 = 0.f, S2 = 0.f, S3 = 0.f;
        const size_t off = ((size_t)bh * 64 * 128 + k) * 128 + v4;
        const u32x2* pu = (const u32x2*)(U + off); u32x2* ps = (u32x2*)(Sb + off); const float* dp = DEC + (size_t)bh * 64 * 128 + k;
#pragma unroll 16
        for (int c = 0; c < 64; ++c) { const u32x2 u = pu[(size_t)c * 4096]; const float d = dp[c * 128];
            u32x2 w; w.x = cvt_pk_bf16(S0, S1); w.y = cvt_pk_bf16(S2, S3); ps[(size_t)c * 4096] = w;
            S0 = d * S0 + bflo(u.x); S1 = d * S1 + bfhi(u.x); S2 = d * S2 + bflo(u.y); S3 = d * S3 + bfhi(u.y); }
    }
}
__device__ __forceinline__ void phase6_hgrn(const Args& a, LAS unsigned char* lds, int tid, int lane, int wave, int G) {
    const bf16* QR = (const bf16*)(a.ws + WS_ARENA + A_QR); const bf16* IR = (const bf16*)(a.ws + WS_ARENA + A_IR); const bf16* LF = (const bf16*)(a.ws + WS_ARENA + A_LF);
    const bf16* SU = (const bf16*)a.out + (size_t)2048 * 128 * 128; const bf16* GR = (const bf16*)(a.ws + WS_ARENA + A_GR); const float* hn = a.in[I_HNORM];
    bf16* OREC = (bf16*)(a.ws + WS_ARENA + A_OATT);
    const int r16 = lane & 15, g = lane >> 4, q4 = (lane & 15) >> 2, p4 = lane & 3, kp = tid & 63, part = tid >> 6, tt = wave & 3, vh = wave >> 2;
    LAS float* BR = (LAS float*)(lds + HL_BR); LAS float* NR = (LAS float*)(lds + HL_NR);
    LAS unsigned char* QT = lds + HL_QT; LAS unsigned char* KT = lds + HL_KT; LAS unsigned char* QE = lds + HL_QE; LAS unsigned char* VV = lds + HL_VV; LAS unsigned char* SS = lds + HL_SS;
    for (int item = blockIdx.x; item < 2048; item += G) {
        const int b = item >> 9, h = (item >> 6) & 7, c = item & 63; const size_t m0 = (size_t)b * SEQ + 64 * c;
        __syncthreads();
#pragma unroll
        for (int i = 0; i < 2; ++i) { const int ch = tid + 512 * i, row = ch >> 4, c16 = ch & 15; *(LAS u32x4*)(VV + row * 288 + c16 * 16) = *(const u32x4*)(IR + (m0 + row) * HW + h * 128 + c16 * 8); }
#pragma unroll
        for (int i = 0; i < 4; ++i) { const int ch = tid + 512 * i, row = ch >> 4, c16 = ch & 15; *(LAS u32x4*)(SS + row * 288 + c16 * 16) = *(const u32x4*)(SU + ((size_t)item * 128 + row) * 128 + c16 * 8); }
        float gl[8][2], bc[8][2];
        hgrn_load_cumsum(LF, m0, h, lds, tid, gl, bc);
        if (part == 3) *(LAS f32x2*)(BR + 2 * kp) = (f32x2){bc[7][0], bc[7][1]};
        __syncthreads();
        const f32x2 br = *(const LAS f32x2*)(BR + 2 * kp);
#pragma unroll
        for (int i = 0; i < 8; ++i) { const int t = 8 * part + i; const unsigned qw = *(const unsigned*)(QR + (m0 + t) * HW + h * 128 + 2 * kp); const float q0 = bflo(qw), q1 = bfhi(qw);
            const float f0 = __expf(gl[i][0]), f1 = __expf(gl[i][1]);
            *(LAS unsigned*)(QT + t * 272 + kp * 4) = cvt_pk_bf16(q0 * __expf(bc[i][0] - br.x), q1 * __expf(bc[i][1] - br.y));
            *(LAS unsigned*)(KT + t * 272 + kp * 4) = cvt_pk_bf16((1.f - f0) * __expf(br.x - bc[i][0]), (1.f - f1) * __expf(br.y - bc[i][1]));
            *(LAS unsigned*)(QE + t * 272 + kp * 4) = cvt_pk_bf16(q0 * __expf(bc[i][0]), q1 * __expf(bc[i][1])); }
        __syncthreads();
        f32x4 sc[4];
#pragma unroll
        for (int st = 0; st < 4; ++st) { sc[st] = (f32x4){0.f, 0.f, 0.f, 0.f};
            if (st <= tt) {
#pragma unroll
                for (int kk = 0; kk < 4; ++kk) { const bf16x8 af = *(const LAS bf16x8*)(KT + (16 * st + r16) * 272 + (32 * kk + 8 * g) * 2), bf = *(const LAS bf16x8*)(QT + (16 * tt + r16) * 272 + (32 * kk + 8 * g) * 2);
                    sc[st] = __builtin_amdgcn_mfma_f32_16x16x32_bf16(af, bf, sc[st], 0, 0, 0); }
                if (st == tt) {
#pragma unroll
                    for (int i = 0; i < 4; ++i) sc[st][i] = (4 * g + i <= r16) ? sc[st][i] : 0.f; } } }
        bf16x8 pf[2]; pf[0] = pack_bf8(sc[0], sc[1]); pf[1] = pack_bf8(sc[2], sc[3]);
        f32x4 o[4]; float ssq = 0.f;
#pragma unroll
        for (int vi = 0; vi < 4; ++vi) { const int vt = 4 * vh + vi; o[vi] = (f32x4){0.f, 0.f, 0.f, 0.f};
#pragma unroll
            for (int pp = 0; pp < 2; ++pp) if (2 * pp <= tt) { const int r0 = 32 * pp + 4 * g + q4;
                const bf16x8 af = tr_pair(VV + r0 * 288 + (16 * vt + 4 * p4) * 2, VV + (r0 + 16) * 288 + (16 * vt + 4 * p4) * 2);
                o[vi] = __builtin_amdgcn_mfma_f32_16x16x32_bf16(af, pf[pp], o[vi], 0, 0, 0); }
#pragma unroll
            for (int kk = 0; kk < 4; ++kk) { const int r0 = 32 * kk + 8 * g + q4;
                const bf16x8 af = tr_pair(SS + r0 * 288 + (16 * vt + 4 * p4) * 2, SS + (r0 + 4) * 288 + (16 * vt + 4 * p4) * 2);
                const bf16x8 bf = *(const LAS bf16x8*)(QE + (16 * tt + r16) * 272 + (32 * kk + 8 * g) * 2);
                o[vi] = __builtin_amdgcn_mfma_f32_16x16x32_bf16(af, bf, o[vi], 0, 0, 0); }
            ssq += (o[vi][0] * o[vi][0] + o[vi][1] * o[vi][1]) + (o[vi][2] * o[vi][2] + o[vi][3] * o[vi][3]); }
        ssq += __shfl_xor(ssq, 16); ssq += __shfl_xor(ssq, 32);
        if (g == 0) NR[vh * 64 + 16 * tt + r16] = ssq;
        __syncthreads();
        const float rstd = rsqrtf((NR[16 * tt + r16] + NR[64 + 16 * tt + r16]) * (1.f / 128.f) + EPS);
        const size_t mrow = m0 + 16 * tt + r16;
#pragma unroll
        for (int vi = 0; vi < 4; ++vi) { const int col = h * 128 + 16 * (4 * vh + vi) + 4 * g; const u32x2 gr = *(const u32x2*)(GR + mrow * HW + col); const f32x4 nn = *(const f32x4*)(hn + col);
            u32x2 w; w.x = cvt_pk_bf16(o[vi][0] * rstd * nn[0] * bflo(gr.x), o[vi][1] * rstd * nn[1] * bfhi(gr.x)); w.y = cvt_pk_bf16(o[vi][2] * rstd * nn[2] * bflo(gr.y), o[vi][3] * rstd * nn[3] * bfhi(gr.y));
            *(u32x2*)(OREC + mrow * 1536 + 512 + col) = w; }
    }
}
__device__ __forceinline__ void phase6_attn_mix(const Args& a, int lane, int wave, int G) {
    const bf16* O12 = (const bf16*)(a.ws + WS_ARENA + A_O12); const float* LSE = (const float*)(a.ws + WS_ARENA + A_LSE); bf16* OATT = (bf16*)(a.ws + WS_ARENA + A_OATT);
    const int gw = blockIdx.x * 8 + wave, NGW = G * 8;
    for (int m = gw; m < T; m += NGW) {
        const int j = lane >> 4, d8 = (lane & 15) * 8;
        const float l0 = LSE[(size_t)m * 12 + j], l1 = LSE[(size_t)m * 12 + 4 + j], l2 = LSE[(size_t)m * 12 + 8 + j];
        const float mx = fmaxf(l0, fmaxf(l1, l2)); const float e0 = __expf(l0 - mx), e1 = __expf(l1 - mx), e2 = __expf(l2 - mx); const float inv = 1.f / (e0 + e1 + e2);
        const float w[3] = {e0 * inv, e1 * inv, e2 * inv};
        float o[8];
#pragma unroll
        for (int q = 0; q < 8; ++q) o[q] = 0.f;
#pragma unroll
        for (int g = 0; g < 3; ++g) { const u32x4 s = *(const u32x4*)(O12 + (size_t)m * ATT_W + (4 * g + j) * 128 + d8);
            o[0] += w[g] * bflo(s.x); o[1] += w[g] * bfhi(s.x); o[2] += w[g] * bflo(s.y); o[3] += w[g] * bfhi(s.y);
            o[4] += w[g] * bflo(s.z); o[5] += w[g] * bfhi(s.z); o[6] += w[g] * bflo(s.w); o[7] += w[g] * bfhi(s.w); }
        u32x4 r; r.x = cvt_pk_bf16(o[0], o[1]); r.y = cvt_pk_bf16(o[2], o[3]); r.z = cvt_pk_bf16(o[4], o[5]); r.w = cvt_pk_bf16(o[6], o[7]);
        *(u32x4*)(OATT + (size_t)m * 1536 + j * 128 + d8) = r;
    }
}

constexpr int R9_ROWB = 4112;
constexpr int R9_PART = 16 * R9_ROWB;
constexpr int R9_RT = R9_PART + 32768;
struct RouteSel { bool sel; int rank; float w; };
__device__ __forceinline__ RouteSel route_token(float logit, int lane, float bias) {
    int e = lane; asm volatile("" : "+v"(e)); const int grp = e >> 3;
    const float score = 1.f / (1.f + expf(-logit)); const float choice = score + bias;
    int rg = 0;
#pragma unroll
    for (int d = 1; d < 8; ++d) { const int oe = (e & ~7) | ((e + d) & 7); const float ov = __shfl(choice, oe); rg += (ov > choice || (ov == choice && oe < e)) ? 1 : 0; }
    float gs = rg < 2 ? choice : 0.f; gs += __shfl_xor(gs, 1); gs += __shfl_xor(gs, 2); gs += __shfl_xor(gs, 4);
    int grank = 0;
#pragma unroll
    for (int d = 1; d < 8; ++d) { const int og = (grp + d) & 7; const float ogs = __shfl(gs, og * 8); grank += (ogs > gs || (ogs == gs && og < grp)) ? 1 : 0; }
    const float masked = grank < 4 ? choice : -INFINITY;
    int rank = 0;
#pragma unroll
    for (int j = 0; j < 64; ++j) { const float ov = __builtin_bit_cast(float, __builtin_amdgcn_readlane(__builtin_bit_cast(int, masked), j)); rank += (ov > masked || (ov == masked && j < e)) ? 1 : 0; }
    RouteSel r; r.sel = rank < 8; r.rank = rank;
    const float ssum = wave_sum(r.sel ? score : 0.f);
    r.w = score / ssum * 2.5f;
    return r;
}
__device__ __forceinline__ void phase9(const Args& a, LAS unsigned char* lds, int tid, int lane, int wave, int G) {
    const float* x = a.in[I_X]; const bf16* Y = (const bf16*)(a.ws + WS_ARENA + A_Y); const float* g2 = a.in[I_POST_MIX]; const float* g3 = a.in[I_PRE_FFN];
    const float* modf = (const float*)(a.ws + WS_MODF); unsigned char* H2F = a.ws + WS_ARENA + A_H2F; bf16* X1 = (bf16*)(a.ws + WS_ARENA + A_X1);
    const bf16* WR = (const bf16*)(a.ws + WS_WR); const float* rbias = a.in[I_RBIAS];
    int* TOPI = (int*)(a.ws + WS_TOPI); float* TOPW = (float*)(a.ws + WS_TOPW); int* TOPP = (int*)(a.ws + WS_TOPP); unsigned* cnt = (unsigned*)(a.ws + WS_CTL) + CW_CNT; int* LIST = (int*)(a.ws + WS_ARENA + A_LIST);
    const int r16 = lane & 15, g = lane >> 4; const float bias = rbias[lane];
    LAS float* PART = (LAS float*)(lds + R9_PART);
    LAS int* RCNT = (LAS int*)(lds + R9_RT); LAS int* RBASE = RCNT + 64; LAS int* RE = RBASE + 64; LAS float* RW = (LAS float*)(RE + 512); LAS int* RP = (LAS int*)(RW + 512);
    for (int gb = blockIdx.x; gb < T / 16; gb += 4 * G) {
        __syncthreads();
        if (tid < 64) RCNT[tid] = 0;
        RE[tid] = -1;
#pragma unroll 1
        for (int q = 0; q < 4; ++q) {
            const int grp = gb + q * G; if (grp >= T / 16) break;
            const int m0 = grp * 16;
            __syncthreads();
#pragma unroll 1
            for (int it = 0; it < 2; ++it) {
                const int m = m0 + 8 * it + wave; const int b = m / SEQ;
                const char* mb = (const char*)(modf + (size_t)b * 12288); const char* yb = (const char*)(Y + (size_t)m * D); const char* xb = (const char*)(x + (size_t)m * D);
                char* ob = (char*)(X1 + (size_t)m * D); char* hb = (char*)(H2F + (size_t)m * D);
                const unsigned o16 = (unsigned)lane * 16u, o8 = (unsigned)lane * 8u, o4 = (unsigned)lane * 4u;
                f32x4 v[8]; float ss = 0.f;
#pragma unroll
                for (int j = 0; j < 8; ++j) { const u32x2 yw = *(const u32x2*)(yb + (o8 + 512u * j)); v[j] = (f32x4){bflo(yw.x), bfhi(yw.x), bflo(yw.y), bfhi(yw.y)}; ss += (v[j][0] * v[j][0] + v[j][1] * v[j][1]) + (v[j][2] * v[j][2] + v[j][3] * v[j][3]); }
                const float rstd = rsqrtf(wave_sum(ss) * (1.f / D) + EPS);
                float ss2 = 0.f;
#pragma unroll
                for (int j = 0; j < 8; ++j) { if (j == 4) asm volatile("" ::: "memory");
                    const unsigned o = o16 + 1024u * j; const f32x4 xv = *(const f32x4*)(xb + o), gg = *(const f32x4*)((const char*)g2 + o), gm = *(const f32x4*)(mb + 16384 + o);
#pragma unroll
                    for (int qq = 0; qq < 4; ++qq) v[j][qq] = xv[qq] + gm[qq] * (v[j][qq] * rstd * gg[qq]);
                    ss2 += (v[j][0] * v[j][0] + v[j][1] * v[j][1]) + (v[j][2] * v[j][2] + v[j][3] * v[j][3]);
                    { u32x2 w1; w1.x = cvt_pk_bf16(v[j][0], v[j][1]); w1.y = cvt_pk_bf16(v[j][2], v[j][3]); *(u32x2*)(ob + (o8 + 512u * j)) = w1; } }
                const float rstd2 = rsqrtf(wave_sum(ss2) * (1.f / D) + EPS);
                LAS unsigned char* hrow = lds + (8 * it + wave) * R9_ROWB;
#pragma unroll
                for (int j = 0; j < 8; ++j) { if (j == 4) asm volatile("" ::: "memory");
                    const unsigned o = o16 + 1024u * j; const f32x4 gg = *(const f32x4*)((const char*)g3 + o), sh = *(const f32x4*)(mb + 24576 + o), sc = *(const f32x4*)(mb + 32768 + o);
                    f32x4 h;
#pragma unroll
                    for (int qq = 0; qq < 4; ++qq) h[qq] = v[j][qq] * rstd2 * gg[qq] * (1.f + sc[qq]) + sh[qq];
                    u32x2 w; w.x = cvt_pk_bf16(h[0], h[1]); w.y = cvt_pk_bf16(h[2], h[3]);
                    *(LAS u32x2*)(hrow + (o8 + 512u * j)) = w;
                    *(unsigned*)(hb + (o4 + 256u * j)) = pk4_fp8(h[0], h[1], h[2], h[3]); }
            }
            __syncthreads();
            {
                f32x4 acc[4];
#pragma unroll
                for (int et = 0; et < 4; ++et) acc[et] = (f32x4){0.f, 0.f, 0.f, 0.f};
#pragma unroll
                for (int ks = 0; ks < 8; ++ks) { const int k = 256 * wave + 32 * ks + 8 * g;
                    const bf16x8 af = *(const LAS bf16x8*)(lds + r16 * R9_ROWB + k * 2);
#pragma unroll
                    for (int et = 0; et < 4; ++et) { const bf16x8 bf = *(const bf16x8*)(WR + (size_t)(16 * et + r16) * D + k);
                        acc[et] = __builtin_amdgcn_mfma_f32_16x16x32_bf16(af, bf, acc[et], 0, 0, 0); } }
#pragma unroll
                for (int et = 0; et < 4; ++et)
#pragma unroll
                    for (int i = 0; i < 4; ++i) PART[(wave * 16 + 4 * g + i) * 64 + 16 * et + r16] = acc[et][i];
            }
            __syncthreads();
#pragma unroll
            for (int tt = 0; tt < 2; ++tt) { const int tok = 2 * wave + tt; float logit = 0.f;
#pragma unroll
                for (int w = 0; w < 8; ++w) logit += PART[(w * 16 + tok) * 64 + lane];
                const RouteSel r = route_token(logit, lane, bias);
                if (r.sel) { const int slot = (q * 16 + tok) * 8 + r.rank;
                    RE[slot] = lane; RW[slot] = r.w; RP[slot] = __hip_atomic_fetch_add(RCNT + lane, 1, __ATOMIC_RELAXED, __HIP_MEMORY_SCOPE_WORKGROUP); } }
        }
        __syncthreads();
        if (tid < 64) RBASE[tid] = (int)atomicAdd(&cnt[tid], (unsigned)RCNT[tid]);
        __syncthreads();
        {   const int e = RE[tid];
            if (e >= 0) { const int grp = gb + (tid >> 7) * G; const int m = grp * 16 + ((tid >> 3) & 15); const int pos = RBASE[e] + RP[tid];
                TOPI[(size_t)m * 8 + (tid & 7)] = e; TOPW[(size_t)m * 8 + (tid & 7)] = RW[tid]; TOPP[(size_t)m * 8 + (tid & 7)] = pos; LIST[(size_t)e * T + pos] = m; } }
    }
}

__device__ __forceinline__ void phase15(const Args& a, LAS unsigned char* lds, int tid, int lane, int wave, int G) {
    const unsigned char* YS = a.ws + WS_ARENA + A_YS; const int* TOPI = (const int*)(a.ws + WS_TOPI); const int* TOPP = (const int*)(a.ws + WS_TOPP); const float* TOPW = (const float*)(a.ws + WS_TOPW); const float* g4 = a.in[I_POST_FFN];
    LAS int* ST = (LAS int*)lds;
    __syncthreads();
    if (tid < 64) pg8::moe_tables((const unsigned*)(a.ws + WS_CTL) + CW_CNT, ST, tid);
    __syncthreads();
    const float* modf = (const float*)(a.ws + WS_MODF); float* out = a.out; const bf16* X1 = (const bf16*)(a.ws + WS_ARENA + A_X1);
    const int gw = blockIdx.x * 8 + wave, NGW = G * 8;
    for (int m = gw; m < T; m += NGW) {
        const int b = m / SEQ; const float* mb = modf + (size_t)b * 12288 + 10240;
        float acc[2][16];
#pragma unroll
        for (int j = 0; j < 2; ++j)
#pragma unroll
            for (int q = 0; q < 16; ++q) acc[j][q] = 0.f;
        int slots[9];
        { const i32x4 e0 = *(const i32x4*)(TOPI + (size_t)m * 8), e1 = *(const i32x4*)(TOPI + (size_t)m * 8 + 4), p0 = *(const i32x4*)(TOPP + (size_t)m * 8), p1 = *(const i32x4*)(TOPP + (size_t)m * 8 + 4);
#pragma unroll
          for (int q = 0; q < 4; ++q) { slots[q] = ST[e0[q]] + p0[q]; slots[4 + q] = ST[e1[q]] + p1[q]; }
          slots[8] = T * 8 + m; }
#pragma unroll 3
        for (int k = 0; k < 9; ++k) { const int slot = slots[k]; const float wk = (k < 8) ? TOPW[(size_t)m * 8 + k] : 1.0f; const u32x4* r = (const u32x4*)(YS + (size_t)slot * D) + lane;
#pragma unroll
            for (int j = 0; j < 2; ++j) { const u32x4 s = r[64 * j]; const unsigned w4[4] = {s.x, s.y, s.z, s.w};
#pragma unroll
                for (int q = 0; q < 4; ++q) { const f32x2 lo = __builtin_amdgcn_cvt_pk_f32_fp8((int)w4[q], false), hi = __builtin_amdgcn_cvt_pk_f32_fp8((int)w4[q], true);
                    acc[j][4 * q] += wk * lo.x; acc[j][4 * q + 1] += wk * lo.y; acc[j][4 * q + 2] += wk * hi.x; acc[j][4 * q + 3] += wk * hi.y; } } }
        float ss = 0.f;
#pragma unroll
        for (int j = 0; j < 2; ++j)
#pragma unroll
            for (int q = 0; q < 16; ++q) ss += acc[j][q] * acc[j][q];
        const float rstd = rsqrtf(wave_sum(ss) * (1.f / (D * SC_YS * SC_YS)) + EPS);
        const float rs = rstd * (1.f / SC_YS);
#pragma unroll
        for (int j = 0; j < 2; ++j) { const int cidx = 16 * lane + 1024 * j; float* op = out + (size_t)m * D + cidx;
#pragma unroll
            for (int hh = 0; hh < 4; ++hh) { const f32x4 g = *(const f32x4*)(g4 + cidx + 4 * hh), gf = *(const f32x4*)(mb + cidx + 4 * hh); const u32x2 xw = *(const u32x2*)(X1 + (size_t)m * D + cidx + 4 * hh); f32x4 o = (f32x4){bflo(xw.x), bfhi(xw.x), bflo(xw.y), bfhi(xw.y)};
#pragma unroll
                for (int q = 0; q < 4; ++q) o[q] += gf[q] * (acc[j][4 * hh + q] * rs * g[q]);
                *(f32x4*)(op + 4 * hh) = o; } }
    }
}

__global__ void __launch_bounds__(512, 2) fwd(Args args) {
    extern __shared__ __attribute__((aligned(16))) unsigned char lds_raw[];
    LAS unsigned char* lds = (LAS unsigned char*)lds_raw;
    volatile LAS unsigned* MISC = (volatile LAS unsigned*)(lds + MISC_OFF);
    const int tid = threadIdx.x, lane = tid & 63, wave = __builtin_amdgcn_readfirstlane(tid >> 6), G = gridDim.x;
    unsigned char* ws = args.ws;
    unsigned* ctl = (unsigned*)(ws + WS_CTL);
    for (int u = tid; u < (LDS_BYTES - MISC_OFF) / 4; u += 512) ((LAS unsigned*)(lds + MISC_OFF))[u] = (u == 16) ? CHW : (u == 17) ? 0xFFFFFFFFu : 0u;
    __syncthreads();
    const int lo = args.ph_lo, hi = args.ph_hi;
    XcdBarrier bar; bar.bar = ctl + CW_BAR; bar.x = 0; bar.st = nullptr;
    if (hi - lo > 1) bar = xcd_barrier_post(ctl + CW_BAR, MISC + 8);
#define IN(k) (lo <= (k) && (k) < hi)
#define SEAM(k) do { if (IN(k) && IN((k) + 1)) xcd_barrier(bar); } while (0)
    unsigned char* ar = ws + WS_ARENA;

    if (IN(0)) { phase0(args, lds, tid, lane, wave, G); } SEAM(0);
    if (IN(1)) { phase1(args, tid, G); } SEAM(1);
    if (IN(2)) { phase2(args, lane, wave, G); } SEAM(2);
    const int NCONV = (G >= 128) ? N_CONV_WG : 0;
    if (IN(3)) {
        unsigned* done = ctl + CW_DONE;
        if ((int)blockIdx.x >= NCONV) {
            const int Gg = G - NCONV, cg = (int)blockIdx.x - NCONV;
            {
                pg8::DenseSched S{(const char*)(ar + A_H), (const char*)(ar + A_WTIN) + (size_t)4608 * D * 2, D * 2, D * 2, D / 64, T / 256, 16, 1, Gg, cg};
                pg8::EpiProj E{(bf16*)(ar + A_QKV), (bf16*)(ar + A_QR), (bf16*)(ar + A_LF), (bf16*)(ar + A_IR), (bf16*)(ar + A_GR), (bf16*)(ar + A_SA), (bf16*)(ar + A_SB), args.in[I_LBL], 18};
                pg8::gemm_phase<pg8::EpiProj, pg8::DenseSched, true>(lds, S, E); }
            {
                pg8::DenseSched S{(const char*)(ar + A_H8), (const char*)(ar + A_WTIN), D, D, D / 128, T / 256, 18, 1, Gg, Gg - 1 - cg, 0x77777777};
                pg8::EpiProj E{(bf16*)(ar + A_QKV), (bf16*)(ar + A_QR), (bf16*)(ar + A_LF), (bf16*)(ar + A_IR), (bf16*)(ar + A_GR), (bf16*)(ar + A_SA), (bf16*)(ar + A_SB), args.in[I_LBL], 0};
                pg8::gemm_phase<pg8::EpiProj, pg8::DenseSched, true, true>(lds, S, E); }
            if (tid == 0) atomicAdd(done, 1u);
        }
        if (IN(4)) conv_queue_until(args, lds, lane, wave, MISC + 16, done, (unsigned)(G - NCONV));
        else conv_queue(args, lds, lane, wave, MISC + 16);
    } SEAM(3);
    if (IN(4)) {
        if ((int)blockIdx.x >= NCONV) {
            const int cg = (int)blockIdx.x - NCONV; const bool gemm_first = ((cg >> 3) & 1) == 0;
            if (!gemm_first) { phase4_hgrn(args, lds, tid, lane, wave, G); phase4_attn(args, lds, tid, lane, wave, G); __syncthreads(); }
            { pg8::DenseSched S{(const char*)(ar + A_H8), (const char*)(ar + A_WG8), D, D, D / 128, T / 256, 16, 1, G - NCONV, cg, 0x77777777};
              pg8::EpiGate E{(unsigned char*)(ar + A_SA), (unsigned char*)(ar + A_SB)};
              pg8::gemm_phase<pg8::EpiGate, pg8::DenseSched, true, true>(lds, S, E); }
            if (gemm_first) { phase4_hgrn(args, lds, tid, lane, wave, G); phase4_attn(args, lds, tid, lane, wave, G); __syncthreads(); }
        } else { phase4_hgrn(args, lds, tid, lane, wave, G); phase4_attn(args, lds, tid, lane, wave, G); __syncthreads(); }
        conv_queue(args, lds, lane, wave, MISC + 16);
    } SEAM(4);
    if (IN(5)) { phase5_scan(args, tid, G); } SEAM(5);
    if (IN(6)) { phase6_hgrn(args, lds, tid, lane, wave, G); phase6_attn_mix(args, lane, wave, G); } SEAM(6);
    if (IN(7)) {
        pg8::DenseSched S{(const char*)(ar + A_OATT), (const char*)(ar + A_WBA), 1536 * 2, 1536 * 2, 1536 / 64, T / 256, D / 256, 1, G, (int)blockIdx.x};
        pg8::EpiMerged E{(const unsigned char*)(ar + A_SA), (const unsigned char*)(ar + A_SB), (unsigned char*)(ar + A_MERGED)};
        pg8::gemm_phase<pg8::EpiMerged, pg8::DenseSched, true>(lds, S, E);
    } SEAM(7);
    if (IN(8)) {
        pg8::DenseSched S{(const char*)(ar + A_MERGED), (const char*)(ar + A_WOUT), D, D, D / 128, T / 256, D / 256, 1, G, (int)blockIdx.x, 0x73737373};
        pg8::EpiF32 E{(bf16*)(ar + A_Y)};
        pg8::gemm_phase<pg8::EpiF32, pg8::DenseSched, true, true>(lds, S, E);
    } SEAM(8);
    if (IN(9)) { phase9(args, lds, tid, lane, wave, G); }
    if (IN(9) && IN(13)) xcd_barrier(bar);
    if (IN(13)) {
        pg8::MoeSched S{(const char*)(ar + A_H2F), (const int*)(ar + A_LIST), (const char*)(ws + WS_WGU), (size_t)1024 * 2048, D, D, D / 128, 4, (const unsigned*)(ws + WS_CTL) + CW_CNT, 0, G, (int)blockIdx.x, 0x77777777, lds};
        S.prepare();
        pg8::EpiSwiglu E{(unsigned char*)(ar + A_HID)};
        pg8::gemm_phase<pg8::EpiSwiglu, pg8::MoeSched, true, true>(lds, S, E);
    } SEAM(13);
    if (IN(14)) {
        pg8::MoeSched S{(const char*)(ar + A_HID), nullptr, (const char*)(ws + WS_WD), (size_t)2048 * 512, DE, DE, DE / 128, 8, (const unsigned*)(ws + WS_CTL) + CW_CNT, 0, G, (int)blockIdx.x, 0x7C7C7C7C, lds};
        S.prepare();
        pg8::EpiDown E{(unsigned char*)(ar + A_YS)};
        pg8::gemm_phase<pg8::EpiDown, pg8::MoeSched, true, true>(lds, S, E);
    } SEAM(14);
    if (IN(15)) { phase15(args, lds, tid, lane, wave, G); }
#undef IN
#undef SEAM
}

extern "C" void kernel_launch(void* const* d_in, const int* in_sizes, int n_in, void* d_out, int out_size, void* d_ws, size_t ws_size, hipStream_t stream) {
    static int grid = 0;
    if (grid == 0) {
        if (n_in != 22 || ws_size < WS_END) { fprintf(stderr, "kernel_launch: unexpected inputs (n_in %d, ws %zu < %zu)\n", n_in, ws_size, (size_t)WS_END); grid = -1; return; }
        int dev = 0, cus = 0, per_cu = 0;
        if (hipGetDevice(&dev) != hipSuccess || hipDeviceGetAttribute(&cus, hipDeviceAttributeMultiprocessorCount, dev) != hipSuccess) { grid = -1; return; }
        if (hipFuncSetAttribute((const void*)fwd, hipFuncAttributeMaxDynamicSharedMemorySize, LDS_BYTES) != hipSuccess) { fprintf(stderr, "kernel_launch: hipFuncSetAttribute failed\n"); grid = -1; return; }
        if (hipOccupancyMaxActiveBlocksPerMultiprocessor(&per_cu, (const void*)fwd, 512, LDS_BYTES) != hipSuccess || per_cu < 1) fprintf(stderr, "kernel_launch: occupancy query says %d\n", per_cu);
        (void)hipGetLastError();
        grid = cus;
    }
    if (grid < 0) return;
    (void)hipMemsetAsync((char*)d_ws + WS_CTL, 0, CTL_ZERO_BYTES, stream);
    Args a{};
    for (int i = 0; i < 22; ++i) a.in[i] = (const float*)d_in[i];
    a.out = (float*)d_out; a.ws = (unsigned char*)d_ws;
    constexpr int NL = MK_N_LAUNCHES;
    for (int li = 0; li < NL; ++li) {
        a.ph_lo = (NL == 1) ? 0 : li; a.ph_hi = (NL == 1) ? NPH : li + 1;
        if (NL != 1 && (li == 10 || li == 11 || li == 12)) continue;
        hipLaunchKernelGGL(fwd, dim3(grid), dim3(512), LDS_BYTES, stream, a);
    }
}
```

```cpp
#include <hip/hip_runtime.h>
#include <cstdio>
#include <cstdint>

#ifndef N_CONV_WG
#define N_CONV_WG 46
#endif
#ifndef MK_N_LAUNCHES
#define MK_N_LAUNCHES 1
#endif

#define GAS __attribute__((address_space(1)))
#define LAS __attribute__((address_space(3)))
typedef unsigned short bf16;
typedef short bf16x8 __attribute__((ext_vector_type(8)));
typedef float f32x4 __attribute__((ext_vector_type(4)));
typedef float f32x2 __attribute__((ext_vector_type(2)));
typedef unsigned u32x4 __attribute__((ext_vector_type(4)));
typedef unsigned u32x2 __attribute__((ext_vector_type(2)));
typedef int i32x4 __attribute__((ext_vector_type(4)));

constexpr int NB = 4, SEQ = 4096, T = NB * SEQ, D = 2048;
constexpr int ATT_W = 1536, INC = 12800, HW = 1024;
constexpr int NE = 64, TOPK = 8, DE = 512;
constexpr int NSLOT = T * TOPK + T;
constexpr float EPS = 1e-6f;
constexpr float SC_GU = 256.f, SC_D = 128.f, SC_YS = 16.f, SC_M = 16.f;
constexpr int NPH = 16;

constexpr size_t WS_CTL = 0, CTL_ZERO_BYTES = 64u << 10;
constexpr int CW_BAR = 4096;
constexpr int CW_CNT = 8192;
constexpr int CW_Q = 8192 + 256;
constexpr int CW_DONE = 8192 + 512;
constexpr size_t WS_MODP = 1u << 20;
constexpr size_t WS_MODF = WS_MODP + (size_t)16 * 4 * 12288 * 4;
constexpr size_t WS_TOPI = WS_MODF + (size_t)4 * 12288 * 4;
constexpr size_t WS_TOPW = WS_TOPI + (size_t)T * 8 * 4;
constexpr size_t WS_TOPP = WS_TOPW + (size_t)T * 8 * 4;
constexpr size_t WS_SLOT_TOK = WS_TOPP + (size_t)T * 8 * 4;
constexpr size_t WS_SLOT_W = WS_SLOT_TOK + (size_t)NSLOT * 4;
constexpr size_t WS_TOK_SLOT = WS_SLOT_W + (size_t)NSLOT * 4;
constexpr size_t WS_TT = WS_TOK_SLOT + (size_t)T * 8 * 4;
constexpr size_t WS_WR = WS_TT + 1024 * 16;
constexpr size_t WS_WGU = 9u << 20;
constexpr size_t WS_WD = WS_WGU + (size_t)65 * 1024 * 2048;
constexpr size_t WS_ARENA = WS_WD + (size_t)65 * 2048 * 512;
static_assert(WS_WR + 256 * 2048 * 2 <= WS_WGU, "small region");
constexpr size_t A_WTIN = 0;
constexpr size_t A_H = A_WTIN + (size_t)INC * D * 2;
constexpr size_t A_QKV = A_H + (size_t)T * D * 2;
constexpr size_t A_MERGED = A_QKV;
constexpr size_t A_QR = A_QKV + (size_t)T * 4608 * 2;
constexpr size_t A_IR = A_QR + (size_t)T * HW * 2;
constexpr size_t A_LF = A_IR + (size_t)T * HW * 2;
constexpr size_t A_Y = A_QR;
constexpr size_t A_GR = A_LF + (size_t)T * HW * 4;
constexpr size_t A_SA = A_GR + (size_t)T * HW * 2;
constexpr size_t A_SB = A_SA + (size_t)T * D * 2;
constexpr size_t A_OATT = A_SB + (size_t)T * D * 2;
constexpr size_t A_OREC = A_OATT + (size_t)T * 512 * 2;
constexpr size_t A_LSE = A_OREC + (size_t)T * HW * 2;
constexpr size_t A_WBA = A_LSE + (size_t)T * 12 * 4;
constexpr size_t A_WBH = A_WBA + (size_t)2048 * 512 * 2;
constexpr size_t A_WOUT = A_WBH + (size_t)2048 * 1024 * 2;
constexpr size_t A_DEC = A_WOUT + (size_t)2048 * 2048 * 2;
constexpr size_t A_O12 = A_DEC + (size_t)2048 * 128 * 4;
constexpr size_t A_H8 = A_O12 + (size_t)T * ATT_W * 2;
constexpr size_t A_WG8 = A_H8 + (size_t)T * D;
constexpr size_t A_X1 = A_WG8 + (size_t)4096 * D;
constexpr size_t A_END1 = A_X1 + (size_t)T * D * 2;
constexpr size_t A_HID = 0;
constexpr size_t A_YS = A_HID + (size_t)NSLOT * DE * 2;
constexpr size_t A_H2 = A_SA;
constexpr size_t A_H2F = A_SB;
constexpr size_t A_RL = 0;
constexpr size_t A_END2 = A_YS + (size_t)NSLOT * D * 2;
constexpr size_t A_LIST = (A_END1 > A_END2 ? A_END1 : A_END2);
constexpr size_t WS_END = WS_ARENA + A_LIST + (size_t)NE * T * 4;
static_assert(A_Y + (size_t)T * D * 4 <= A_GR, "Y overlay");
static_assert(A_H2 >= A_Y + (size_t)T * D * 4 && A_H2 + (size_t)T * D * 2 <= A_END2, "H2 placement");
static_assert(WS_END <= 1187639552ull, "workspace budget (sum of inputs)");

constexpr int RING_BYTES = 131072;
constexpr int LDS_BYTES = 163840;
constexpr int MISC_OFF = LDS_BYTES - 256;

#define RLX_AGENT __ATOMIC_RELAXED, __HIP_MEMORY_SCOPE_AGENT
typedef __bf16 bf16x2_t __attribute__((ext_vector_type(2)));
__device__ __forceinline__ unsigned cvt_pk_bf16(float lo, float hi) { const f32x2 v = {lo, hi}; const bf16x2_t r = __builtin_convertvector(v, bf16x2_t); return __builtin_bit_cast(unsigned, r); }
__device__ __forceinline__ unsigned pk4_gate(const f32x4 s) { const unsigned a = (unsigned)(fmaxf(s[0] * 255.f, 1.f) + 0.5f), b = (unsigned)(fmaxf(s[1] * 255.f, 1.f) + 0.5f), c = (unsigned)(fmaxf(s[2] * 255.f, 1.f) + 0.5f), d = (unsigned)(fmaxf(s[3] * 255.f, 1.f) + 0.5f);
    return a | (b << 8) | (c << 16) | (d << 24); }
__device__ __forceinline__ f32x4 up4_gate(unsigned w) { return (f32x4){(float)(w & 0xffu), (float)((w >> 8) & 0xffu), (float)((w >> 16) & 0xffu), (float)(w >> 24)}; }
__device__ __forceinline__ unsigned pk4_fp8(float a, float b, float c, float d) { int w = __builtin_amdgcn_cvt_pk_fp8_f32(a, b, 0, false); w = __builtin_amdgcn_cvt_pk_fp8_f32(c, d, w, true); return (unsigned)w; }
__device__ __forceinline__ float bf2f(unsigned short b) { return __uint_as_float(((unsigned)b) << 16); }
__device__ __forceinline__ float bflo(unsigned w) { return __uint_as_float(w << 16); }
__device__ __forceinline__ float bfhi(unsigned w) { return __uint_as_float(w & 0xffff0000u); }
__device__ __forceinline__ float sigmoidf_(float v) { return __builtin_amdgcn_rcpf(1.0f + __expf(-v)); }
__device__ __forceinline__ float siluf_(float v) { return v * sigmoidf_(v); }
typedef short s16x4 __attribute__((ext_vector_type(4)));
__device__ __forceinline__ s16x4 tr_read4(const LAS unsigned char* p) { return __builtin_amdgcn_ds_read_tr16_b64_v4i16((LAS s16x4*)p); }
__device__ __forceinline__ float wave_sum(float v) {
#pragma unroll
    for (int o = 1; o < 64; o <<= 1) v += __shfl_xor(v, o);
    return v;
}
__device__ __forceinline__ float wave_max(float v) {
#pragma unroll
    for (int o = 1; o < 64; o <<= 1) v = fmaxf(v, __shfl_xor(v, o));
    return v;
}

#define XB_TMO      128
#define XB_XCNT(j)  (256  + 64 * (j))
#define XB_XSUB(j)  (1280 + 64 * (j))
#define XB_XGEN(j)  (2304 + 64 * (j))
#define XB_TOP      3328
#define XB_TOPGEN   3392
#define XCD_BAR_WORDS 3456
#define XB_SPIN_CAP (1u << 18)
__device__ __forceinline__ unsigned xb_ld(unsigned* p)              { return __hip_atomic_load(p, __ATOMIC_RELAXED, __HIP_MEMORY_SCOPE_AGENT); }
__device__ __forceinline__ unsigned xb_add(unsigned* p, unsigned v) { return __hip_atomic_fetch_add(p, v, __ATOMIC_RELAXED, __HIP_MEMORY_SCOPE_AGENT); }
__device__ __forceinline__ unsigned xb_xcc_id() { return (unsigned)__builtin_amdgcn_s_getreg((3 << 11) | 20) & 0xFu; }
#define XB_SPIN(cond, bar) do { unsigned _sp = 0; while (cond) { __builtin_amdgcn_s_sleep(1); \
    if ((++_sp & 255u) == 0u) { if (xb_ld(&(bar)[XB_TMO])) break; if (_sp > XB_SPIN_CAP) { atomicAdd(&(bar)[XB_TMO], 1u); break; } } } } while (0)
struct XcdBarrier { unsigned* bar; unsigned x; volatile LAS unsigned* st; };
__device__ __forceinline__ XcdBarrier xcd_barrier_post(unsigned* bar, volatile LAS unsigned* st) {
    XcdBarrier b; b.bar = bar; b.x = xb_xcc_id(); b.st = st;
    if (threadIdx.x == 0) (void)xb_add(&bar[XB_XCNT(b.x)], 1u);
    return b;
}
__device__ __forceinline__ void xcd_barrier_complete(unsigned* bar, unsigned x, unsigned& nloc, unsigned& nx) {
    const unsigned G = gridDim.x * gridDim.y * gridDim.z;
    unsigned sum, cnt, mine, sp = 0u;
    for (;;) {
        sum = 0u; cnt = 0u; mine = 0u;
#pragma unroll
        for (unsigned j = 0; j < 16; ++j) { const unsigned c = xb_ld(&bar[XB_XCNT(j)]); sum += c; cnt += (c > 0u) ? 1u : 0u; mine = (j == x) ? c : mine; }
        if (sum == G) break;
        __builtin_amdgcn_s_sleep(1);
        if ((++sp & 255u) == 0u) { if (xb_ld(&bar[XB_TMO])) break; if (sp > XB_SPIN_CAP) { atomicAdd(&bar[XB_TMO], 1u); break; } }
    }
    nloc = mine > 0u ? mine : 1u; nx = 0u;
#pragma unroll
    for (unsigned j = 0; j < 16; ++j) nx |= (xb_ld(&bar[XB_XCNT(j)]) > 0u ? 1u : 0u) << j;
    if (nx == 0u) nx = 1u;
}
__device__ __forceinline__ void xcd_barrier(const XcdBarrier& b) {
    asm volatile("s_waitcnt vmcnt(0)" ::: "memory");
    __syncthreads();
    if (threadIdx.x == 0) {
        unsigned* bar = b.bar;
        __builtin_amdgcn_s_waitcnt(0);
        unsigned nloc = b.st[0], nx = b.st[1];
        if (nloc == 0u) { xcd_barrier_complete(bar, b.x, nloc, nx); b.st[0] = nloc; b.st[1] = nx; }
        const unsigned old = xb_add(&bar[XB_XSUB(b.x)], 1u);
        const unsigned gen = old / nloc;
        if (old + 1u == (gen + 1u) * nloc) {
            __builtin_amdgcn_fence(__ATOMIC_RELEASE, "agent");
            asm volatile("s_waitcnt vmcnt(0)" ::: "memory");
            const unsigned nxc = (unsigned)__builtin_popcount(nx);
            const unsigned og = xb_add(&bar[XB_TOP], 1u);
            const unsigned tg = og / nxc;
            if (og + 1u == (tg + 1u) * nxc) {
#pragma unroll
                for (unsigned j = 0; j < 16; ++j) if ((nx >> j) & 1u) xb_add(&bar[XB_XGEN(j)], 1u);
            } else XB_SPIN(xb_ld(&bar[XB_XGEN(b.x)]) == gen, bar);
            __builtin_amdgcn_fence(__ATOMIC_ACQUIRE, "agent");
            asm volatile("s_waitcnt vmcnt(0)" ::: "memory");
        } else {
            XB_SPIN(xb_ld(&bar[XB_XGEN(b.x)]) == gen, bar);
            __builtin_amdgcn_fence(__ATOMIC_ACQUIRE, "agent");
            asm volatile("s_waitcnt vmcnt(0)" ::: "memory");
        }
    }
    __syncthreads();
}

namespace pg8 {
constexpr int BM = 256, BK = 64, HALF = 128, HTB = HALF * BK * 2, NXCD = 8, WGM = 8;
__host__ __device__ __forceinline__ int lds_byte(int r, int c) { const int st = (r >> 4) * 2 + (c >> 5), rr = r & 15, cc = c & 31, ob = rr * 64 + cc * 2; return st * 1024 + (ob ^ (((ob >> 9) & 1) << 5)); }
__host__ __device__ __forceinline__ void stage_rc(int b, int& R, int& C) { const int st = b / 1024, sb = b % 1024, swz = sb ^ (((sb >> 9) & 1) << 5); R = (st >> 1) * 16 + swz / 64; C = (st & 1) * 32 + (swz % 64) / 2; }
__host__ __device__ __forceinline__ int perm256(int bj, int R) { const int wc = R >> 5, n = (R >> 4) & 1, fq = (R >> 2) & 3, r = R & 3; return 64 * wc + 16 * fq + 8 * bj + 4 * n + r; }

struct Unit { int row0, pn, e, nvalid, idx; };

__device__ __forceinline__ bool order_tile(int i, int G, int c, int nM, int nN, int& pm, int& pn) {
    const int nwg = nM * nN; const long L = (long)i * G + c; if (L >= nwg) return false;
    int wgid = (int)L; { const int q = nwg / NXCD, r = nwg % NXCD, xcd = wgid % NXCD, off = wgid / NXCD; wgid = (xcd < r ? xcd * (q + 1) : r * (q + 1) + (xcd - r) * q) + off; }
    const int nig = WGM * nN, gid = wgid / nig, fm = gid * WGM, gsz = (nM - fm) < WGM ? (nM - fm) : WGM;
    pm = fm + ((wgid % nig) % gsz); pn = (wgid % nig) / gsz; return true;
}

typedef int i32x8 __attribute__((ext_vector_type(8)));
template <class Epi, class Sched, bool ALIGN_EPI, bool FP8 = false>
__device__ __forceinline__ void gemm_phase(LAS unsigned char* lds, const Sched& S, const Epi& E) {
    const int tid = threadIdx.x, wid = __builtin_amdgcn_readfirstlane(tid >> 6), lane = tid & 63, wr = wid >> 2, wc = wid & 3, fr = lane & 15, fq = lane >> 4;
    const int wscale = S.wscale;
    int nt = S.nt; asm volatile("" : "+s"(nt));
    const unsigned ldb2 = (unsigned)S.ldbB;
    unsigned voffB[2];
#pragma unroll
    for (int i = 0; i < 2; ++i) { int R, C; stage_rc(tid * 16 + i * 8192, R, C); voffB[i] = (unsigned)perm256(0, R) * ldb2 + (unsigned)C * 2u; }
    const size_t hstepB = (size_t)8 * ldb2;
#define PG8_AOFFS(unit) do { int RA_[2], CA2_[2]; _Pragma("unroll") for (int i_ = 0; i_ < 2; ++i_) { int R_, C_; stage_rc((threadIdx.x & 511) * 16 + i_ * 8192, R_, C_); RA_[i_] = R_; CA2_[i_] = C_ * 2; } S.aoffs(unit, RA_, CA2_, voffA); } while (0)
    const size_t kstep = (size_t)(BK * 2);
    const unsigned ldsw = (unsigned)wid * 1024u;
    const int aoff = lds_byte(wr * 64 + fr, fq * 8), boff = lds_byte(wc * 32 + fr, fq * 8);
#define PG8_SA(b, h) (((b) * 2 + (h)) * HTB)
#define PG8_SB(b, h) ((4 + (b) * 2 + (h)) * HTB)
#define PG8_STAGE(bufoff, gbase, voff) do { _Pragma("unroll") for (int _i = 0; _i < 2; ++_i) \
        __builtin_amdgcn_global_load_lds((const unsigned*)((const char*)(gbase) + (voff)[_i]), (LAS unsigned*)(lds + (bufoff) + ldsw + _i * 8192), 16, 0, 0); } while (0)
#define PG8_LDA(dst, b, h) do { _Pragma("unroll") for (int m = 0; m < 4; ++m) _Pragma("unroll") for (int k = 0; k < 2; ++k) dst[m][k] = *(const LAS bf16x8*)(lds + PG8_SA(b, h) + aoff + m * 2048 + k * 1024); } while (0)
#define PG8_LDB(dst, b, h) do { _Pragma("unroll") for (int n = 0; n < 2; ++n) _Pragma("unroll") for (int k = 0; k < 2; ++k) dst[n][k] = *(const LAS bf16x8*)(lds + PG8_SB(b, h) + boff + n * 2048 + k * 1024); } while (0)
#define PG8_MMA(ai, bj, At, Bt) do { __builtin_amdgcn_s_setprio(1); _Pragma("unroll") for (int m = 0; m < 4; ++m) _Pragma("unroll") for (int n = 0; n < 2; ++n) _Pragma("unroll") for (int k = 0; k < 2; ++k) \
        acc[ai][bj][m][n] = __builtin_amdgcn_mfma_f32_16x16x32_bf16(Bt[n][k], At[m][k], acc[ai][bj][m][n], 0, 0, 0); __builtin_amdgcn_s_setprio(0); } while (0)
#define PG8_LDA8(dst, b, h) do { _Pragma("unroll") for (int m = 0; m < 4; ++m) { const i32x4 lo_ = *(const LAS i32x4*)(lds + PG8_SA(b, h) + aoff + m * 2048), hi_ = *(const LAS i32x4*)(lds + PG8_SA(b, h) + aoff + m * 2048 + 1024); \
        dst[m] = __builtin_shufflevector(lo_, hi_, 0, 1, 2, 3, 4, 5, 6, 7); } } while (0)
#define PG8_LDB8(dst, b, h) do { _Pragma("unroll") for (int n = 0; n < 2; ++n) { const i32x4 lo_ = *(const LAS i32x4*)(lds + PG8_SB(b, h) + boff + n * 2048), hi_ = *(const LAS i32x4*)(lds + PG8_SB(b, h) + boff + n * 2048 + 1024); \
        dst[n] = __builtin_shufflevector(lo_, hi_, 0, 1, 2, 3, 4, 5, 6, 7); } } while (0)
#define PG8_MMA8(ai, bj, A8, B8) do { __builtin_amdgcn_s_setprio(1); _Pragma("unroll") for (int m = 0; m < 4; ++m) _Pragma("unroll") for (int n = 0; n < 2; ++n) \
        acc[ai][bj][m][n] = __builtin_amdgcn_mfma_scale_f32_16x16x128_f8f6f4(B8[n], A8[m], acc[ai][bj][m][n], 0, 0, 0, wscale, 0, 0x7F7F7F7F); __builtin_amdgcn_s_setprio(0); } while (0)
#define PG8_XLDA(b, h) do { if constexpr (FP8) PG8_LDA8(At8, b, h); else PG8_LDA(At, b, h); } while (0)
#define PG8_XLDB0(b, h) do { if constexpr (FP8) PG8_LDB8(B08, b, h); else PG8_LDB(B0, b, h); } while (0)
#define PG8_XLDB1(b, h) do { if constexpr (FP8) PG8_LDB8(B18, b, h); else PG8_LDB(B1, b, h); } while (0)
#define PG8_MM0(ai, bj) do { if constexpr (FP8) PG8_MMA8(ai, bj, At8, B08); else PG8_MMA(ai, bj, At, B0); } while (0)
#define PG8_MM1(ai, bj) do { if constexpr (FP8) PG8_MMA8(ai, bj, At8, B18); else PG8_MMA(ai, bj, At, B1); } while (0)
#define PG8_WAIT_V(n) asm volatile("s_waitcnt vmcnt(" #n ")" ::: "memory")
#define PG8_WAIT_L(n) asm volatile("s_waitcnt lgkmcnt(" #n ")" ::: "memory")
#define PG8_BAR __builtin_amdgcn_s_barrier()
#define PG8_SCHED __builtin_amdgcn_sched_barrier(0)
    Unit cur, nxt; int ui = 0;
    if (!S.next(0, cur)) return;
    f32x4 acc[2][2][4][2];
#pragma unroll
    for (int a = 0; a < 2; ++a)
#pragma unroll
        for (int b = 0; b < 2; ++b)
#pragma unroll
            for (int m = 0; m < 4; ++m)
#pragma unroll
                for (int n = 0; n < 2; ++n) acc[a][b][m][n] = (f32x4){0.f, 0.f, 0.f, 0.f};
    bf16x8 At[4][2], B0[2][2], B1[2][2]; i32x8 At8[4], B08[2], B18[2];
    const char* const cA = S.abase();
    const char* cB = S.bptr(cur);
    unsigned voffA[2][2];
    PG8_AOFFS(cur);
    PG8_STAGE(PG8_SB(0, 0), cB, voffB); PG8_STAGE(PG8_SB(0, 1), cB + hstepB, voffB); PG8_STAGE(PG8_SA(0, 0), cA, voffA[0]); PG8_STAGE(PG8_SA(0, 1), cA, voffA[1]);
    if (wr == 1) PG8_BAR;
    PG8_WAIT_V(2); PG8_BAR;
    PG8_STAGE(PG8_SB(1, 0), cB + kstep, voffB); PG8_STAGE(PG8_SA(1, 0), cA + kstep, voffA[0]); PG8_STAGE(PG8_SB(1, 1), cB + hstepB + kstep, voffB);
    PG8_WAIT_V(6); PG8_BAR;
    for (;;) {
        const bool has_next = S.next(ui + 1, nxt);
        const char* nB = has_next ? S.bptr(nxt) : cB;
#define PG8_TRIP() do { \
            const bool last = (t == nt - 2); \
            const char* a1 = cA + (size_t)(t + 1) * kstep; \
            const char* a2 = cA + (last ? (size_t)0 : (size_t)(t + 2) * kstep); const char* b2 = last ? nB : cB + (size_t)(t + 2) * kstep; \
            const char* a3 = a2 + kstep; const char* b3 = b2 + kstep; \
            PG8_XLDB0(0, 0); PG8_XLDB1(0, 1); PG8_SCHED; PG8_XLDA(0, 0); PG8_STAGE(PG8_SA(1, 1), a1, voffA[1]); \
            if (last && has_next) PG8_AOFFS(nxt);        \
            PG8_WAIT_V(8); PG8_WAIT_L(0); PG8_BAR; PG8_MM0(0, 0); PG8_MM1(0, 1); PG8_BAR; PG8_SCHED; \
            PG8_XLDA(0, 1); PG8_STAGE(PG8_SB(0, 0), b2, voffB); PG8_STAGE(PG8_SB(0, 1), b2 + hstepB, voffB); PG8_STAGE(PG8_SA(0, 0), a2, voffA[0]); \
            PG8_WAIT_V(8); PG8_WAIT_L(0); PG8_BAR; PG8_MM0(1, 0); PG8_MM1(1, 1); PG8_BAR; PG8_SCHED; \
            PG8_XLDB0(1, 0); PG8_XLDB1(1, 1); PG8_SCHED; PG8_XLDA(1, 0); PG8_STAGE(PG8_SA(0, 1), a2, voffA[1]); \
            PG8_WAIT_V(8); PG8_WAIT_L(0); PG8_BAR; PG8_MM0(0, 0); PG8_MM1(0, 1); PG8_BAR; PG8_SCHED; \
            PG8_XLDA(1, 1); PG8_STAGE(PG8_SB(1, 0), b3, voffB); PG8_STAGE(PG8_SB(1, 1), b3 + hstepB, voffB); PG8_STAGE(PG8_SA(1, 0), a3, voffA[0]); \
            PG8_WAIT_V(8); PG8_WAIT_L(0); PG8_BAR; PG8_MM0(1, 0); PG8_MM1(1, 1); PG8_BAR; PG8_SCHED; \
        } while (0)
        if constexpr (Epi::MID_T > 0) {
            for (int t = 0; t < Epi::MID_T; t += 2) PG8_TRIP();
            E.mid(acc, cur, wr, wc, fr, fq);
            for (int t = Epi::MID_T; t < nt; t += 2) PG8_TRIP();
        } else {
            for (int t = 0; t < nt; t += 2) PG8_TRIP();
        }
#pragma unroll
        for (int a = 0; a < 2; ++a)
#pragma unroll
            for (int b = 0; b < 2; ++b)
#pragma unroll
                for (int m = 0; m < 4; ++m) asm volatile("" : "+v"(acc[a][b][m][0]), "+v"(acc[a][b][m][1]));
        if constexpr (ALIGN_EPI) { if (wr == 0) PG8_BAR; }
        E(acc, cur, wr, wc, fr, fq);
        if (!has_next) break;
#pragma unroll
        for (int a = 0; a < 2; ++a)
#pragma unroll
            for (int b = 0; b < 2; ++b)
#pragma unroll
                for (int m = 0; m < 4; ++m)
#pragma unroll
                    for (int n = 0; n < 2; ++n) acc[a][b][m][n] = (f32x4){0.f, 0.f, 0.f, 0.f};
        cur = nxt; cB = nB; ++ui;
        if constexpr (ALIGN_EPI) { if (wr == 1) PG8_BAR; }
    }
    PG8_WAIT_V(0);
    if constexpr (!ALIGN_EPI) { if (wr == 0) PG8_BAR; }
    PG8_BAR;
#undef PG8_AOFFS
#undef PG8_TRIP
#undef PG8_SA
#undef PG8_SB
#undef PG8_STAGE
#undef PG8_LDA
#undef PG8_LDB
#undef PG8_MMA
#undef PG8_MMA8
#undef PG8_LDA8
#undef PG8_LDB8
#undef PG8_XLDA
#undef PG8_XLDB0
#undef PG8_XLDB1
#undef PG8_MM0
#undef PG8_MM1
#undef PG8_WAIT_V
#undef PG8_WAIT_L
#undef PG8_BAR
#undef PG8_SCHED
}

struct DenseSched {
    const char* A; const char* Bt; int ldaB, ldbB, nt; int nM, nN, nK, G, c; int wscale = 0x7F7F7F7F;
    __device__ __forceinline__ bool next(int i, Unit& u) const {
        int pm, pn; if (!order_tile(i, G, c, nM, nN * nK, pm, pn)) return false;
        u.row0 = pm * BM; u.nvalid = BM; u.idx = i;
        if (nK > 1) { u.pn = 0; u.e = pn; } else { u.pn = pn; u.e = 0; }
        return true;
    }
    __device__ __forceinline__ const char* abase() const { return A; }
    __device__ __forceinline__ const char* bptr(const Unit& u) const { return Bt + (size_t)u.pn * BM * ldbB + (size_t)u.e * nt * 128; }
    __device__ __forceinline__ void aoffs(const Unit& u, const int (&RA)[2], const int (&CA2)[2], unsigned (&v)[2][2]) const {
#pragma unroll
        for (int h = 0; h < 2; ++h)
#pragma unroll
            for (int i = 0; i < 2; ++i) v[h][i] = (unsigned)(u.row0 + h * HALF + RA[i]) * (unsigned)ldaB + (unsigned)CA2[i] + (unsigned)(u.e * nt * 128);
    }
};
constexpr int MOE_MAXU = 24, MOE_UL_OFF = 131072, MOE_TOK_OFF = 131072 + 512, MOE_ST_OFF = MOE_TOK_OFF + MOE_MAXU * 1024;
__device__ __forceinline__ void moe_tables(const unsigned* cnt, LAS int* ST, int lane) {
    const int c = (int)__hip_atomic_load(cnt + lane, __ATOMIC_RELAXED, __HIP_MEMORY_SCOPE_AGENT), nt_ = (c + 255) >> 8;
    int s = c, tb = nt_;
#pragma unroll
    for (int o = 1; o < 64; o <<= 1) { const int s2 = __shfl_up(s, o), t2 = __shfl_up(tb, o); if (lane >= o) { s += s2; tb += t2; } }
    ST[lane] = s - c; ST[72 + lane] = tb - nt_;
    if (lane == 63) { ST[64] = s; ST[72 + 64] = tb; ST[65] = s + T; ST[72 + 65] = tb + T / 256; }
}
struct MoeSched {
    const char* A; const int* list; const char* Bt; size_t bstride; int ldaB, ldbB, nt, nN; const unsigned* cnt; int NT; int G, c; int wscale; LAS unsigned char* lds;
    __device__ __forceinline__ void prepare() {
        const int tid = threadIdx.x; LAS int* ST = (LAS int*)(lds + MOE_ST_OFF);
        if (tid < 64) moe_tables(cnt, ST, tid);
        __syncthreads();
        NT = __builtin_amdgcn_readfirstlane(ST[72 + 65]);
        if (tid < MOE_MAXU) { int pm, pn; i32x4 ent = (i32x4){-1, 0, 0, 0};
            if (order_tile(tid, G, c, NT, nN, pm, pn)) { int e = 0; while (ST[72 + e + 1] <= pm) ++e;
                const int j = pm - ST[72 + e], ce = ST[e + 1] - ST[e]; ent = (i32x4){e, ST[e] + 256 * j, min(256, ce - 256 * j), pn}; }
            *(LAS i32x4*)(lds + MOE_UL_OFF + tid * 16) = ent; }
        __syncthreads();
        if (list) {
#pragma unroll
            for (int r = 0; r < MOE_MAXU * 256 / 512; ++r) { const int idx = tid + 512 * r, i = idx >> 8, t = idx & 255; const i32x4 ent = *(const LAS i32x4*)(lds + MOE_UL_OFF + i * 16);
                int tok = 0;
                if (ent.x == NE) tok = ent.y - T * 8 + t; else if (ent.x >= 0 && t < ent.z) tok = list[(size_t)ent.x * T + (ent.y - ST[ent.x]) + t];
                *(LAS int*)(lds + MOE_TOK_OFF + idx * 4) = tok; }
        }
        __syncthreads();
    }
    __device__ __forceinline__ bool next(int i, Unit& u) const {
        if (i >= MOE_MAXU) return false;
        const i32x4 ent = *(const LAS i32x4*)(lds + MOE_UL_OFF + i * 16);
        const int ex = __builtin_amdgcn_readfirstlane(ent.x); if (ex < 0) return false;
        u.e = ex; u.row0 = __builtin_amdgcn_readfirstlane(ent.y); u.nvalid = __builtin_amdgcn_readfirstlane(ent.z); u.pn = __builtin_amdgcn_readfirstlane(ent.w); u.idx = i; return true;
    }
    __device__ __forceinline__ const char* abase() const { return A; }
    __device__ __forceinline__ const char* bptr(const Unit& u) const { return Bt + (size_t)u.e * bstride + (size_t)u.pn * BM * ldbB; }
    __device__ __forceinline__ void aoffs(const Unit& u, const int (&RA)[2], const int (&CA2)[2], unsigned (&v)[2][2]) const {
#pragma unroll
        for (int h = 0; h < 2; ++h)
#pragma unroll
            for (int i = 0; i < 2; ++i) { const int rt = h * HALF + RA[i]; int ridx = u.row0 + rt;
                if (list) ridx = *(const LAS int*)(lds + MOE_TOK_OFF + u.idx * 1024 + rt * 4);
                v[h][i] = (unsigned)ridx * (unsigned)ldaB + (unsigned)CA2[i]; }
    }
};

#define EPI_ROWS_BEGIN _Pragma("unroll") for (int ai = 0; ai < 2; ++ai) _Pragma("unroll") for (int m = 0; m < 4; ++m) { const int rt = ai * HALF + wr * 64 + m * 16 + fr; const size_t row = (size_t)(u.row0 + rt);
#define EPI_ROWS_END }
#define EPI_V4(q) acc[ai][(q) >> 1][m][(q) & 1]
__device__ __forceinline__ u32x4 pack8(const f32x4 v0, const f32x4 v1) { u32x4 w; w.x = cvt_pk_bf16(v0[0], v0[1]); w.y = cvt_pk_bf16(v0[2], v0[3]); w.z = cvt_pk_bf16(v1[0], v1[1]); w.w = cvt_pk_bf16(v1[2], v1[3]); return w; }

struct EpiProj {
    static constexpr int MID_T = 0;
    bf16* QKV; bf16* QR; bf16* LF; bf16* IR; bf16* GR; bf16* SA; bf16* SB; const float* lbl; int pn0;
    __device__ __forceinline__ void operator()(const f32x4 (&acc)[2][2][4][2], const Unit& u, int wr, int wc, int fr, int fq) const {
        const int pn = u.pn + pn0; int kind, ldc, colt; bf16* base;
        if (pn < 18)      { kind = 0; base = QKV; ldc = 4608; colt = pn * 256; }
        else if (pn < 22) { kind = 0; base = QR;  ldc = 1024; colt = (pn - 18) * 256; }
        else if (pn < 26) { kind = 3; base = nullptr; ldc = 1024; colt = (pn - 22) * 256; }
        else if (pn < 30) { kind = 0; base = IR;  ldc = 1024; colt = (pn - 26) * 256; }
        else if (pn < 34) { kind = 1; base = GR;  ldc = 1024; colt = (pn - 30) * 256; }
        else if (pn < 42) { kind = 2; base = SA;  ldc = 2048; colt = (pn - 34) * 256; }
        else              { kind = 2; base = SB;  ldc = 2048; colt = (pn - 42) * 256; }
        const int col0 = colt + wc * 64 + 16 * fq;
        if (kind == 3) {
            f32x4 lb[4];
#pragma unroll
            for (int q = 0; q < 4; ++q) { const f32x4 l0 = *(const f32x4*)(lbl + col0 + 4 * q), l1 = *(const f32x4*)(lbl + 1024 + col0 + 4 * q);
#pragma unroll
                for (int j = 0; j < 4; ++j) lb[q][j] = sigmoidf_(l0[j] - l1[j]); }
            EPI_ROWS_BEGIN
                bf16* rowp = LF + row * 1024 + col0; f32x4 o[4];
#pragma unroll
                for (int q = 0; q < 4; ++q) { const f32x4 v = EPI_V4(q);
#pragma unroll
                    for (int j = 0; j < 4; ++j) { const float l = lb[q][j]; o[q][j] = __logf(l + (1.f - l) * sigmoidf_(v[j])); } }
                *(u32x4*)rowp = pack8(o[0], o[1]); *(u32x4*)(rowp + 8) = pack8(o[2], o[3]);
            EPI_ROWS_END
        } else {
            EPI_ROWS_BEGIN
                bf16* rowp = base + row * ldc + col0;
#pragma unroll
                for (int hq = 0; hq < 2; ++hq) { f32x4 v0 = EPI_V4(2 * hq), v1 = EPI_V4(2 * hq + 1);
                    if (kind == 1) {
#pragma unroll
                        for (int j = 0; j < 4; ++j) { v0[j] = siluf_(v0[j]); v1[j] = siluf_(v1[j]); } }
                    if (kind == 2) {
#pragma unroll
                        for (int j = 0; j < 4; ++j) { v0[j] = sigmoidf_(v0[j]); v1[j] = sigmoidf_(v1[j]); } }
                    *(u32x4*)(rowp + 8 * hq) = pack8(v0, v1); }
            EPI_ROWS_END
        }
    }
};
struct EpiGate {
    static constexpr int MID_T = 0;
    unsigned char* SA; unsigned char* SB;
    __device__ __forceinline__ void operator()(const f32x4 (&acc)[2][2][4][2], const Unit& u, int wr, int wc, int fr, int fq) const {
        unsigned char* base = u.pn < 8 ? SA : SB; const int col0 = (u.pn & 7) * 256 + wc * 64 + 16 * fq;
        EPI_ROWS_BEGIN
            u32x4 o;
#pragma unroll
            for (int q = 0; q < 4; ++q) { f32x4 v = EPI_V4(q);
#pragma unroll
                for (int j = 0; j < 4; ++j) v[j] = sigmoidf_(v[j]);
                o[q] = pk4_gate(v); }
            *(u32x4*)(base + row * D + col0) = o;
        EPI_ROWS_END
    }
};
struct EpiMerged {
    static constexpr int MID_T = 8;
    const unsigned char* SA; const unsigned char* SB; unsigned char* MG;
    __device__ __forceinline__ void mid(f32x4 (&acc)[2][2][4][2], const Unit& u, int wr, int wc, int fr, int fq) const {
        const unsigned base = (unsigned)(u.row0 + wr * 64 + fr) * D + (unsigned)(u.pn * 256 + wc * 64 + 16 * fq);
        const char* sa = (const char*)SA; const char* sb = (const char*)SB;
#pragma unroll
        for (int ai = 0; ai < 2; ++ai)
#pragma unroll
            for (int m = 0; m < 4; ++m) {
                const unsigned off = base + (unsigned)((ai * HALF + m * 16) * D); const u32x4 ga = *(const u32x4*)(sa + off), gb = *(const u32x4*)(sb + off);
#pragma unroll
                for (int q = 0; q < 4; ++q) { const f32x4 fa = up4_gate(ga[q]), fb = up4_gate(gb[q]); f32x4& v = acc[ai][q >> 1][m][q & 1];
#pragma unroll
                    for (int j = 0; j < 4; ++j) v[j] *= fa[j] * __builtin_amdgcn_rcpf(fb[j]); }
                if (m & 1) asm volatile("" ::: "memory");
            }
    }
    __device__ __forceinline__ void operator()(const f32x4 (&acc)[2][2][4][2], const Unit& u, int wr, int wc, int fr, int fq) const {
        const int col0 = u.pn * 256 + wc * 64 + 16 * fq;
        EPI_ROWS_BEGIN
            const u32x4 g = *(const u32x4*)(SB + row * D + col0); u32x4 o;
#pragma unroll
            for (int q = 0; q < 4; ++q) { const f32x4 fb = up4_gate(g[q]); f32x4 v = EPI_V4(q);
#pragma unroll
                for (int j = 0; j < 4; ++j) v[j] *= fb[j] * (SC_M / 255.f);
                o[q] = pk4_fp8(v[0], v[1], v[2], v[3]); }
            *(u32x4*)(MG + row * D + col0) = o;
        EPI_ROWS_END
    }
};
struct EpiF32 {
    static constexpr int MID_T = 0;
    bf16* Y;
    __device__ __forceinline__ void operator()(const f32x4 (&acc)[2][2][4][2], const Unit& u, int wr, int wc, int fr, int fq) const {
        const int col0 = u.pn * 256 + wc * 64 + 16 * fq;
        EPI_ROWS_BEGIN
            bf16* p = Y + row * D + col0;
            *(u32x4*)p = pack8(EPI_V4(0), EPI_V4(1)); *(u32x4*)(p + 8) = pack8(EPI_V4(2), EPI_V4(3));
        EPI_ROWS_END
    }
};
struct EpiRouter {
    static constexpr int MID_T = 0;
    float* RL;
    __device__ __forceinline__ void operator()(const f32x4 (&acc)[2][2][4][2], const Unit& u, int wr, int wc, int fr, int fq) const {
        if (wc == 0) {
            EPI_ROWS_BEGIN
                float* p = RL + ((size_t)u.e * T + row) * 64 + 16 * fq;
#pragma unroll
                for (int q = 0; q < 4; ++q) *(f32x4*)(p + 4 * q) = EPI_V4(q);
            EPI_ROWS_END
        }
    }
};
struct EpiSwiglu {
    static constexpr int MID_T = 0;
    unsigned char* HID;
    __device__ __forceinline__ void operator()(const f32x4 (&acc)[2][2][4][2], const Unit& u, int wr, int wc, int fr, int fq) const {
        const int col0 = u.pn * 128 + wc * 32 + 8 * fq;
        EPI_ROWS_BEGIN
            if (rt < u.nvalid) { f32x4 v0, v1;
#pragma unroll
                for (int j = 0; j < 4; ++j) { v0[j] = siluf_(acc[ai][0][m][0][j]) * acc[ai][1][m][0][j]; v1[j] = siluf_(acc[ai][0][m][1][j]) * acc[ai][1][m][1][j]; }
                u32x2 w; w.x = pk4_fp8(v0[0], v0[1], v0[2], v0[3]); w.y = pk4_fp8(v1[0], v1[1], v1[2], v1[3]);
                *(u32x2*)(HID + row * DE + col0) = w; }
        EPI_ROWS_END
    }
};
struct EpiDown {
    static constexpr int MID_T = 0;
    unsigned char* YS;
    __device__ __forceinline__ void operator()(const f32x4 (&acc)[2][2][4][2], const Unit& u, int wr, int wc, int fr, int fq) const {
        const int col0 = u.pn * 256 + wc * 64 + 16 * fq;
        EPI_ROWS_BEGIN
            if (rt < u.nvalid) { u32x4 o;
                { const f32x4 v = EPI_V4(0); o.x = pk4_fp8(v[0], v[1], v[2], v[3]); } { const f32x4 v = EPI_V4(1); o.y = pk4_fp8(v[0], v[1], v[2], v[3]); }
                { const f32x4 v = EPI_V4(2); o.z = pk4_fp8(v[0], v[1], v[2], v[3]); } { const f32x4 v = EPI_V4(3); o.w = pk4_fp8(v[0], v[1], v[2], v[3]); }
                *(u32x4*)(YS + row * D + col0) = o; }
        EPI_ROWS_END
    }
};
}

struct Args { const float* in[22]; float* out; unsigned char* ws; int ph_lo, ph_hi; };
enum { I_X = 0, I_C, I_WADA, I_BADA, I_PRE_MIX, I_POST_MIX, I_WIN, I_LBL, I_HNORM, I_WBA, I_WBH, I_WOUT, I_PRE_FFN, I_POST_FFN, I_WR, I_RBIAS, I_WGE, I_WUE, I_WDE, I_WGS, I_WUS, I_WDS };

template <bool F8>
__device__ __forceinline__ void p0_item64(const float* W, int Kmat, int N, unsigned char* WT, size_t dst_estride, int mode, float scale, LAS unsigned char* scr, int item, int lane) {
    const int nblk = N / 64, kb = item / nblk, nb = item % nblk, kpm = Kmat / 64, e = kb / kpm, k0 = 64 * (kb % kpm), n0 = 64 * nb;
    const float* src = W + ((size_t)e * Kmat + k0) * N + n0 + 4 * (lane & 15);
    const int r16 = lane & 15, g = lane >> 4, q4 = (lane & 15) >> 2, p4 = lane & 3;
    f32x4 v[16];
#pragma unroll
    for (int i = 0; i < 16; ++i) v[i] = __builtin_nontemporal_load((const f32x4*)(src + (size_t)(4 * i + g) * N));
#pragma unroll
    for (int i = 0; i < 16; ++i) { u32x2 w; w.x = cvt_pk_bf16(v[i][0] * scale, v[i][1] * scale); w.y = cvt_pk_bf16(v[i][2] * scale, v[i][3] * scale);
        *(LAS u32x2*)(scr + (4 * i + g) * 144 + r16 * 8) = w; }
    constexpr int ESZ = F8 ? 1 : 2;
#pragma unroll
    for (int c = 0; c < 4; ++c) {
        const int n = n0 + 16 * c + r16; int dr = n; if (mode) dr = 256 * (n >> 7) + 16 * ((n & 127) >> 3) + (n & 7) + (mode == 2 ? 8 : 0);
        unsigned char* drow = WT + (size_t)e * dst_estride + ((size_t)dr * Kmat + k0) * ESZ;
        if constexpr (F8) {
            unsigned o[4];
#pragma unroll
            for (int t = 0; t < 4; ++t) { const s16x4 r = tr_read4(scr + (16 * g + 4 * t + q4) * 144 + (16 * c + 4 * p4) * 2);
                o[t] = pk4_fp8(bf2f((unsigned short)r[0]), bf2f((unsigned short)r[1]), bf2f((unsigned short)r[2]), bf2f((unsigned short)r[3])); }
            *(u32x4*)(drow + 16 * g) = (u32x4){o[0], o[1], o[2], o[3]};
        } else {
#pragma unroll
            for (int ks = 0; ks < 2; ++ks) { const s16x4 lo = tr_read4(scr + (32 * ks + 8 * g + q4) * 144 + (16 * c + 4 * p4) * 2), hi = tr_read4(scr + (32 * ks + 8 * g + 4 + q4) * 144 + (16 * c + 4 * p4) * 2);
                *(bf16x8*)(drow + (32 * ks + 8 * g) * 2) = __builtin_shufflevector(lo, hi, 0, 1, 2, 3, 4, 5, 6, 7); }
        }
    }
}
__device__ __forceinline__ void phase0(const Args& a, LAS unsigned char* lds, int tid, int lane, int wave, int G) {
    unsigned char* ws = a.ws;
    {
        LAS float* red = (LAS float*)lds;
        const float* c = a.in[I_C]; const float* wada = a.in[I_WADA];
        float* modp = (float*)(ws + WS_MODP);
        for (int item = blockIdx.x; item < 256; item += G) {
            const int ks = item >> 4, ns = item & 15;
            f32x4 acc[4][3];
#pragma unroll
            for (int b = 0; b < 4; ++b)
#pragma unroll
                for (int j = 0; j < 3; ++j) acc[b][j] = (f32x4){0.f, 0.f, 0.f, 0.f};
#pragma unroll 4
            for (int kk = 0; kk < 16; ++kk) {
                const int k = ks * 128 + wave * 16 + kk;
                float s[4];
#pragma unroll
                for (int b = 0; b < 4; ++b) { const float cv = c[b * D + k]; s[b] = cv / (1.f + __expf(-cv)); }
                const f32x4* wrow = (const f32x4*)(wada + (size_t)k * 12288 + ns * 768);
#pragma unroll
                for (int j = 0; j < 3; ++j) { const f32x4 w = wrow[lane + 64 * j];
#pragma unroll
                    for (int b = 0; b < 4; ++b) acc[b][j] += w * s[b]; }
            }
#pragma unroll
            for (int b = 0; b < 4; ++b)
#pragma unroll
                for (int j = 0; j < 3; ++j) *(LAS f32x4*)(red + (wave * 4 + b) * 768 + 4 * (lane + 64 * j)) = acc[b][j];
            __syncthreads();
            for (int o = tid; o < 4 * 768; o += 512) { const int b = o / 768, n = o % 768; float s = 0.f;
#pragma unroll
                for (int w = 0; w < 8; ++w) s += red[(w * 4 + b) * 768 + n];
                modp[((size_t)ks * 4 + b) * 12288 + ns * 768 + n] = s; }
            __syncthreads();
        }
    }
    {
        u32x4* z = (u32x4*)(ws + WS_WR + (size_t)64 * 2048 * 2); const int nz = 192 * 2048 * 2 / 16;
        for (int i = blockIdx.x * 512 + tid; i < nz; i += G * 512) z[i] = (u32x4){0u, 0u, 0u, 0u};
    }
    __syncthreads();
    LAS unsigned char* scr = lds + wave * 9216;
    const int gw = blockIdx.x * 8 + wave, NGW = G * 8;
    for (int it = gw; it < 32 * 200; it += NGW) {
        if (it % 200 < 72) p0_item64<true>(a.in[I_WIN], 2048, INC, ws + WS_ARENA + A_WTIN, 0, 0, SC_GU, scr, it, lane);
        else if (it % 200 < 136) p0_item64<false>(a.in[I_WIN], 2048, INC, ws + WS_ARENA + A_WTIN, 0, 0, 1.f, scr, it, lane);
        else p0_item64<true>(a.in[I_WIN], 2048, INC, ws + WS_ARENA + A_WG8 - (size_t)8704 * 2048, 0, 0, SC_GU, scr, it, lane); }
}
struct ConvDesc { const float* W; unsigned char* WT; size_t estride; int Kmat, N, mode, f8; float scale; int item; int ldd; };
__device__ __forceinline__ bool conv_desc(const Args& a, unsigned it, ConvDesc& d) {
    constexpr int I_BA = 8 * 32, I_BH = 16 * 32, I_OUT = 32 * 32, I_R = 32 * 1, I_GE = 64 * 32 * 8, I_DE = 64 * 8 * 32, I_GS = 32 * 8, I_DS = 8 * 32;
    constexpr unsigned NIT = I_BA + I_BH + I_OUT + I_R + 2 * I_GE + I_DE + 2 * I_GS + I_DS;
    if (it >= NIT) return false;
    unsigned char* ws = a.ws; unsigned char* wgu = ws + WS_WGU; unsigned char* wd = ws + WS_WD; unsigned char* ar = ws + WS_ARENA;
    int r = (int)it;
    if (r < I_BA) { d = ConvDesc{a.in[I_WBA], ar + A_WBA, 0, 512, 2048, 0, 0, 1.f, r, 1536}; return true; } r -= I_BA;
    if (r < I_BH) { d = ConvDesc{a.in[I_WBH], ar + A_WBA + 512 * 2, 0, 1024, 2048, 0, 0, 1.f, r, 1536}; return true; } r -= I_BH;
    if (r < I_OUT) { d = ConvDesc{a.in[I_WOUT], ar + A_WOUT, 0, 2048, 2048, 0, 1, SC_GU, r, 2048}; return true; } r -= I_OUT;
    if (r < I_R) { d = ConvDesc{a.in[I_WR], ws + WS_WR, 0, 2048, 64, 0, 0, 1.f, r, 2048}; return true; } r -= I_R;
    if (r < I_GE) { d = ConvDesc{a.in[I_WGE], wgu, (size_t)1024 * 2048, 2048, 512, 1, 1, SC_GU, r, 2048}; return true; } r -= I_GE;
    if (r < I_GE) { d = ConvDesc{a.in[I_WUE], wgu, (size_t)1024 * 2048, 2048, 512, 2, 1, SC_GU, r, 2048}; return true; } r -= I_GE;
    if (r < I_DE) { d = ConvDesc{a.in[I_WDE], wd, (size_t)2048 * 512, 512, 2048, 0, 1, SC_D, r, 512}; return true; } r -= I_DE;
    if (r < I_GS) { d = ConvDesc{a.in[I_WGS], wgu + (size_t)64 * 1024 * 2048, 0, 2048, 512, 1, 1, SC_GU, r, 2048}; return true; } r -= I_GS;
    if (r < I_GS) { d = ConvDesc{a.in[I_WUS], wgu + (size_t)64 * 1024 * 2048, 0, 2048, 512, 2, 1, SC_GU, r, 2048}; return true; } r -= I_GS;
    d = ConvDesc{a.in[I_WDS], wd + (size_t)64 * 2048 * 512, 0, 512, 2048, 0, 1, SC_D, r, 512}; return true;
}
__device__ __forceinline__ void conv_load(const ConvDesc& d, int lane, f32x4 (&v)[16]) {
    const int nblk = d.N / 64, kb = d.item / nblk, nb = d.item % nblk, kpm = d.Kmat / 64, e = kb / kpm, k0 = 64 * (kb % kpm), n0 = 64 * nb;
    const float* src = d.W + ((size_t)e * d.Kmat + k0) * d.N + n0 + 4 * (lane & 15);
#pragma unroll
    for (int i = 0; i < 16; ++i) v[i] = __builtin_nontemporal_load((const f32x4*)(src + (size_t)(4 * i + (lane >> 4)) * d.N));
}
__device__ __forceinline__ void conv_finish(const ConvDesc& d, int lane, const f32x4 (&v)[16], LAS unsigned char* scr) {
    const int nblk = d.N / 64, kb = d.item / nblk, nb = d.item % nblk, kpm = d.Kmat / 64, e = kb / kpm, k0 = 64 * (kb % kpm), n0 = 64 * nb;
    const int r16 = lane & 15, g = lane >> 4, q4 = (lane & 15) >> 2, p4 = lane & 3; const float scale = d.scale;
#pragma unroll
    for (int i = 0; i < 16; ++i) { u32x2 w; w.x = cvt_pk_bf16(v[i][0] * scale, v[i][1] * scale); w.y = cvt_pk_bf16(v[i][2] * scale, v[i][3] * scale);
        *(LAS u32x2*)(scr + (4 * i + g) * 144 + r16 * 8) = w; }
#pragma unroll
    for (int c = 0; c < 4; ++c) {
        const int n = n0 + 16 * c + r16; int dr = n; if (d.mode) dr = 256 * (n >> 7) + 16 * ((n & 127) >> 3) + (n & 7) + (d.mode == 2 ? 8 : 0);
        if (d.f8) {
            unsigned char* drow = d.WT + (size_t)e * d.estride + ((size_t)dr * d.ldd + k0);
            unsigned o[4];
#pragma unroll
            for (int t = 0; t < 4; ++t) { const s16x4 r = tr_read4(scr + (16 * g + 4 * t + q4) * 144 + (16 * c + 4 * p4) * 2);
                o[t] = pk4_fp8(bf2f((unsigned short)r[0]), bf2f((unsigned short)r[1]), bf2f((unsigned short)r[2]), bf2f((unsigned short)r[3])); }
            *(u32x4*)(drow + 16 * g) = (u32x4){o[0], o[1], o[2], o[3]};
        } else {
            unsigned char* drow = d.WT + (size_t)e * d.estride + ((size_t)dr * d.ldd + k0) * 2;
#pragma unroll
            for (int ks = 0; ks < 2; ++ks) { const s16x4 lo = tr_read4(scr + (32 * ks + 8 * g + q4) * 144 + (16 * c + 4 * p4) * 2), hi = tr_read4(scr + (32 * ks + 8 * g + 4 + q4) * 144 + (16 * c + 4 * p4) * 2);
                *(bf16x8*)(drow + (32 * ks + 8 * g) * 2) = __builtin_shufflevector(lo, hi, 0, 1, 2, 3, 4, 5, 6, 7); }
        }
    }
}
constexpr unsigned CHW = 32;
__device__ __forceinline__ unsigned conv_ticket(unsigned* q, volatile LAS unsigned* cw, int lane) {
    LAS unsigned long long* S = (LAS unsigned long long*)(cw); LAS unsigned* NXT = (LAS unsigned*)(cw + 2);
    for (;;) {
        unsigned long long old = 0ull; if (lane == 0) old = __hip_atomic_fetch_add(S, 1ull, __ATOMIC_RELAXED, __HIP_MEMORY_SCOPE_WORKGROUP);
        const unsigned taken = (unsigned)__builtin_amdgcn_readfirstlane((int)(unsigned)old), base = (unsigned)__builtin_amdgcn_readfirstlane((int)(unsigned)(old >> 32));
        if (taken < CHW) {
            if (taken == CHW / 2 && lane == 0) { const unsigned b = atomicAdd(q, CHW); __hip_atomic_store(NXT, b + 1u, __ATOMIC_RELAXED, __HIP_MEMORY_SCOPE_WORKGROUP); }
            return base + taken;
        }
        if (taken == CHW) {
            if (lane == 0) {
                unsigned nb;
                if (base == 0xFFFFFFFFu) nb = atomicAdd(q, CHW);
                else { unsigned v; while ((v = __hip_atomic_load(NXT, __ATOMIC_RELAXED, __HIP_MEMORY_SCOPE_WORKGROUP)) == 0u) __builtin_amdgcn_s_sleep(1); nb = v - 1u; __hip_atomic_store(NXT, 0u, __ATOMIC_RELAXED, __HIP_MEMORY_SCOPE_WORKGROUP); }
                (void)__hip_atomic_exchange(S, (unsigned long long)nb << 32, __ATOMIC_RELAXED, __HIP_MEMORY_SCOPE_WORKGROUP);
            }
        } else {
            if (lane == 0) { while ((unsigned)(__hip_atomic_load(S, __ATOMIC_RELAXED, __HIP_MEMORY_SCOPE_WORKGROUP) >> 32) == base) __builtin_amdgcn_s_sleep(1); }
        }
    }
}
__device__ __forceinline__ void conv_queue(const Args& a, LAS unsigned char* lds, int lane, int wave, volatile LAS unsigned* cw) {
    unsigned* q = (unsigned*)(a.ws + WS_CTL) + CW_Q;
    LAS unsigned char* scr = lds + wave * 9216;
    ConvDesc dc, dn; f32x4 va[16], vb[16];
    bool have = conv_desc(a, conv_ticket(q, cw, lane), dc);
    if (have) conv_load(dc, lane, va);
    while (have) {
        const bool hn = conv_desc(a, conv_ticket(q, cw, lane), dn);
        if (hn) conv_load(dn, lane, vb);
        conv_finish(dc, lane, va, scr);
        if (!hn) break;
        have = conv_desc(a, conv_ticket(q, cw, lane), dc);
        if (have) conv_load(dc, lane, va);
        conv_finish(dn, lane, vb, scr);
    }
}

__device__ __forceinline__ void conv_queue_until(const Args& a, LAS unsigned char* lds, int lane, int wave, volatile LAS unsigned* cw, unsigned* done_word, unsigned need) {
    unsigned* q = (unsigned*)(a.ws + WS_CTL) + CW_Q;
    LAS unsigned char* scr = lds + wave * 9216;
    for (;;) {
        unsigned dn_ = 0u;
        if (lane == 0) { dn_ = __hip_atomic_load(done_word, __ATOMIC_RELAXED, __HIP_MEMORY_SCOPE_AGENT); }
        if ((unsigned)__builtin_amdgcn_readfirstlane((int)dn_) >= need) break;
        const unsigned it0 = conv_ticket(q, cw, lane), it1 = conv_ticket(q, cw, lane);
        ConvDesc d0, d1; f32x4 v0[16], v1[16];
        const bool h0 = conv_desc(a, it0, d0), h1 = conv_desc(a, it1, d1);
        if (!h0 && !h1) break;
        if (h0) conv_load(d0, lane, v0); if (h1) conv_load(d1, lane, v1);
        if (h0) conv_finish(d0, lane, v0, scr); if (h1) conv_finish(d1, lane, v1, scr);
    }
}

__device__ __forceinline__ void phase1(const Args& a, int tid, int G) {
    const float* modp = (const float*)(a.ws + WS_MODP); float* modf = (float*)(a.ws + WS_MODF); const float* bada = a.in[I_BADA];
    for (int o = blockIdx.x * 512 + tid; o < 4 * 12288; o += G * 512) { float s = 0.f;
#pragma unroll
        for (int k = 0; k < 16; ++k) s += modp[(size_t)k * 4 * 12288 + o];
        modf[o] = s + bada[o % 12288]; }
}

__device__ __forceinline__ void phase2(const Args& a, LAS unsigned char* lds, int tid, int lane, int wave, int G) {
    const float* x = a.in[I_X]; const float* g1 = a.in[I_PRE_MIX]; const float* modf = (const float*)(a.ws + WS_MODF);
    bf16* H = (bf16*)(a.ws + WS_ARENA + A_H); unsigned char* H8 = a.ws + WS_ARENA + A_H8;
    LAS float* PA = (LAS float*)lds; LAS float* PB = PA + 2048;
    for (int r0 = blockIdx.x * 64; r0 < T; r0 += G * 64) {
        const int b = r0 / SEQ; const float* mb = modf + (size_t)b * 12288;
        f32x4 vn[8];
#pragma unroll
        for (int j = 0; j < 8; ++j) vn[j] = ((const f32x4*)(x + (size_t)(r0 + wave) * D) + lane)[64 * j];
        __syncthreads();
        { const int c = tid * 4; const f32x4 g = *(const f32x4*)(g1 + c), sh = *(const f32x4*)(mb + c), sc = *(const f32x4*)(mb + 2048 + c); f32x4 qa;
#pragma unroll
          for (int k = 0; k < 4; ++k) qa[k] = g[k] * (1.f + sc[k]);
          *(LAS f32x4*)(PA + c) = qa; *(LAS f32x4*)(PB + c) = sh; }
        __syncthreads();
#pragma unroll 1
        for (int k = 0; k < 8; ++k) {
            const int m = r0 + wave + 8 * k;
            f32x4 v[8]; float ss = 0.f;
#pragma unroll
            for (int j = 0; j < 8; ++j) { v[j] = vn[j]; ss += (v[j][0] * v[j][0] + v[j][1] * v[j][1]) + (v[j][2] * v[j][2] + v[j][3] * v[j][3]); }
            { const int mn = r0 + wave + 8 * (k < 7 ? k + 1 : 7);
#pragma unroll
              for (int j = 0; j < 8; ++j) vn[j] = ((const f32x4*)(x + (size_t)mn * D) + lane)[64 * j]; }
            const float rstd = rsqrtf(wave_sum(ss) * (1.f / D) + EPS);
            u32x2* o = (u32x2*)(H + (size_t)m * D) + lane;
#pragma unroll
            for (int j = 0; j < 8; ++j) { const int cidx = 4 * lane + 256 * j; const f32x4 pa = *(const LAS f32x4*)(PA + cidx), pb = *(const LAS f32x4*)(PB + cidx);
                f32x4 h;
#pragma unroll
                for (int q = 0; q < 4; ++q) h[q] = v[j][q] * rstd * pa[q] + pb[q];
                u32x2 w; w.x = cvt_pk_bf16(h[0], h[1]); w.y = cvt_pk_bf16(h[2], h[3]); o[64 * j] = w;
                *(unsigned*)(H8 + (size_t)m * D + cidx) = pk4_fp8(h[0], h[1], h[2], h[3]); }
        }
    }
}

__device__ __forceinline__ bf16x8 tr_pair(const LAS unsigned char* p0, const LAS unsigned char* p1) {
    const s16x4 lo = __builtin_amdgcn_ds_read_tr16_b64_v4i16((LAS s16x4*)p0);
    const s16x4 hi = __builtin_amdgcn_ds_read_tr16_b64_v4i16((LAS s16x4*)p1);
    return __builtin_shufflevector(lo, hi, 0, 1, 2, 3, 4, 5, 6, 7);
}
__device__ __forceinline__ bf16x8 pack_bf8(const f32x4 a0, const f32x4 a1) { u32x4 w; w.x = cvt_pk_bf16(a0[0], a0[1]); w.y = cvt_pk_bf16(a0[2], a0[3]); w.z = cvt_pk_bf16(a1[0], a1[1]); w.w = cvt_pk_bf16(a1[2], a1[3]); return __builtin_bit_cast(bf16x8, w); }
constexpr int AT_KS = 272, AT_VS = 288, AT_VOFF = 256 * AT_KS;
constexpr float LOG2E = 1.4426950408889634f, LN2 = 0.6931471805599453f;
__device__ __forceinline__ void phase4_attn(const Args& a, LAS unsigned char* lds, int tid, int lane, int wave, int G) {
    const bf16* QKV = (const bf16*)(a.ws + WS_ARENA + A_QKV); bf16* O12 = (bf16*)(a.ws + WS_ARENA + A_O12); float* LSE = (float*)(a.ws + WS_ARENA + A_LSE);
    LAS unsigned char* Kl = lds; LAS unsigned char* Vl = lds + AT_VOFF;
    const int r16 = lane & 15, g = lane >> 4, q4 = (lane & 15) >> 2, p4 = lane & 3;
    __syncthreads();
    for (int u = tid; u < 16 * AT_VS / 4; u += 512) ((LAS unsigned*)(Vl + 256 * AT_VS))[u] = 0u;
    u32x4 kvr[8], vvr[8]; bf16x8 qfr[4];
#define AT_LOAD(it_) do { const int rn_ = (it_) & 31, bh_ = (it_) >> 5, h_ = bh_ % 12, b_ = bh_ / 12, grp_ = h_ >> 2; \
        const int dil_ = grp_ == 0 ? 1 : (grp_ == 1 ? 4 : 16), nb_ = 32 / dil_, r_ = rn_ / nb_, n_ = rn_ % nb_; const size_t rs_ = (size_t)dil_ * 4608; \
        const bf16* base_ = QKV + ((size_t)b_ * SEQ + r_) * 4608 + h_ * 128; \
        _Pragma("unroll") for (int i = 0; i < 8; ++i) { const int row = (tid >> 4) + 32 * i, c16 = tid & 15; const int l = 128 * (n_ - 1) + row; \
            const bf16* p = base_ + (size_t)(l < 0 ? 0 : l) * rs_ + c16 * 8; kvr[i] = *(const u32x4*)(p + 1536); vvr[i] = *(const u32x4*)(p + 3072); \
            if (l < 0) { kvr[i] = (u32x4){0u, 0u, 0u, 0u}; vvr[i] = (u32x4){0u, 0u, 0u, 0u}; } } \
        const int lq_ = 128 * n_ + 16 * wave + r16; \
        _Pragma("unroll") for (int kk = 0; kk < 4; ++kk) qfr[kk] = *(const bf16x8*)(base_ + (size_t)lq_ * rs_ + 32 * kk + 8 * g); } while (0)
    if ((int)blockIdx.x < 1536) AT_LOAD((int)blockIdx.x);
    for (int item = blockIdx.x; item < 1536; item += G) {
        const int rn = item & 31, bh = item >> 5, h = bh % 12, b = bh / 12, grp = h >> 2;
        const int dil = grp == 0 ? 1 : (grp == 1 ? 4 : 16), nb = 32 / dil, r = rn / nb, n = rn % nb;
        __syncthreads();
#pragma unroll
        for (int i = 0; i < 8; ++i) { const int row = (tid >> 4) + 32 * i, c16 = tid & 15;
            *(LAS u32x4*)(Kl + row * AT_KS + c16 * 16) = kvr[i]; *(LAS u32x4*)(Vl + row * AT_VS + c16 * 16) = vvr[i]; }
        const int lq = 128 * n + 16 * wave + r16;
        bf16x8 qf[4];
#pragma unroll
        for (int kk = 0; kk < 4; ++kk) qf[kk] = qfr[kk];
        { const int nit = min(item + G, 1535); AT_LOAD(nit); }
        __syncthreads();
        f32x4 s[9];
#pragma unroll
        for (int kt = 0; kt < 9; ++kt) { s[kt] = (f32x4){0.f, 0.f, 0.f, 0.f};
#pragma unroll
            for (int kk = 0; kk < 4; ++kk) { const bf16x8 kf = *(const LAS bf16x8*)(Kl + (16 * (wave + kt) + r16) * AT_KS + (32 * kk + 8 * g) * 2);
                s[kt] = __builtin_amdgcn_mfma_f32_16x16x32_bf16(kf, qf[kk], s[kt], 0, 0, 0); } }
        const float slope2 = exp2f(-8.0f * (float)(h + 1) / 12.0f) * (float)dil * LOG2E, c1 = 0.08838834764831845f * LOG2E;
        float mx = -INFINITY;
#pragma unroll
        for (int kt = 0; kt < 9; ++kt)
#pragma unroll
            for (int i = 0; i < 4; ++i) { const int jj = 128 + r16 - 16 * kt - 4 * g - i, ki = 16 * (wave + kt) + 4 * g + i;
                const bool valid = (jj >= 0) && (jj <= 128) && (n > 0 || ki >= 128);
                const float v = valid ? s[kt][i] * c1 - slope2 * (float)jj : -INFINITY; s[kt][i] = v; mx = fmaxf(mx, v); }
        mx = fmaxf(mx, __shfl_xor(mx, 16)); mx = fmaxf(mx, __shfl_xor(mx, 32));
        float sum = 0.f;
#pragma unroll
        for (int kt = 0; kt < 9; ++kt)
#pragma unroll
            for (int i = 0; i < 4; ++i) { const float p = __builtin_amdgcn_exp2f(s[kt][i] - mx); s[kt][i] = p; sum += p; }
        sum += __shfl_xor(sum, 16); sum += __shfl_xor(sum, 32);
        bf16x8 pf[5];
#pragma unroll
        for (int pp = 0; pp < 5; ++pp) pf[pp] = pack_bf8(s[2 * pp], (2 * pp + 1 < 9) ? s[(2 * pp + 1 < 9) ? 2 * pp + 1 : 8] : (f32x4){0.f, 0.f, 0.f, 0.f});
        const float inv = 1.f / sum;
        const size_t mq = (size_t)b * SEQ + (size_t)lq * dil + r;
#pragma unroll
        for (int dt = 0; dt < 8; ++dt) { f32x4 o = (f32x4){0.f, 0.f, 0.f, 0.f};
#pragma unroll
            for (int pp = 0; pp < 5; ++pp) { const int r0 = 16 * (wave + 2 * pp) + 4 * g + q4;
                const bf16x8 vf = tr_pair(Vl + r0 * AT_VS + (16 * dt + 4 * p4) * 2, Vl + (r0 + 16) * AT_VS + (16 * dt + 4 * p4) * 2);
                o = __builtin_amdgcn_mfma_f32_16x16x32_bf16(vf, pf[pp], o, 0, 0, 0); }
            u32x2 w; w.x = cvt_pk_bf16(o[0] * inv, o[1] * inv); w.y = cvt_pk_bf16(o[2] * inv, o[3] * inv);
            *(u32x2*)(O12 + mq * ATT_W + h * 128 + 16 * dt + 4 * g) = w; }
        if (g == 0) LSE[mq * 12 + h] = (mx + __log2f(sum)) * LN2;
    }
}

#undef AT_LOAD
constexpr int HL_PT = 0, HL_BR = 4096, HL_NR = 5120, HL_QT = 8192, HL_KT = HL_QT + 64 * 272, HL_QE = HL_KT + 64 * 272, HL_VV = HL_QE + 64 * 272, HL_SS = HL_VV + 64 * 288, HL_KH = HL_QT;
static_assert(HL_SS + 128 * 288 <= MISC_OFF, "HGRN LDS map");
__device__ __forceinline__ void hgrn_lf_load(const bf16* LF, size_t m0, int h, int tid, unsigned (&lf)[8]) {
    const int kp = tid & 63, part = tid >> 6;
#pragma unroll
    for (int i = 0; i < 8; ++i) lf[i] = *(const unsigned*)(LF + (m0 + 8 * part + i) * HW + h * 128 + 2 * kp);
}
__device__ __forceinline__ void hgrn_cumsum(const unsigned (&lf)[8], LAS unsigned char* lds, int tid, float (&gl)[8][2], float (&bc)[8][2]) {
    const int kp = tid & 63, part = tid >> 6; LAS float* PT = (LAS float*)(lds + HL_PT);
    float run0 = 0.f, run1 = 0.f;
#pragma unroll
    for (int i = 0; i < 8; ++i) { const f32x2 gv = {bflo(lf[i]), bfhi(lf[i])}; gl[i][0] = gv.x; gl[i][1] = gv.y; run0 += gv.x; run1 += gv.y; bc[i][0] = run0; bc[i][1] = run1; }
    *(LAS f32x2*)(PT + part * 128 + 2 * kp) = (f32x2){run0, run1};
    __syncthreads();
    float off0 = 0.f, off1 = 0.f;
    for (int p = 0; p < part; ++p) { const f32x2 t = *(const LAS f32x2*)(PT + p * 128 + 2 * kp); off0 += t.x; off1 += t.y; }
#pragma unroll
    for (int i = 0; i < 8; ++i) { bc[i][0] += off0; bc[i][1] += off1; }
}
__device__ __forceinline__ void phase4_hgrn(const Args& a, LAS unsigned char* lds, int tid, int lane, int wave, int G) {
    const bf16* IR = (const bf16*)(a.ws + WS_ARENA + A_IR); const bf16* LF = (const bf16*)(a.ws + WS_ARENA + A_LF);
    bf16* SU = (bf16*)a.out; float* DEC = (float*)(a.ws + WS_ARENA + A_DEC);
    const int r16 = lane & 15, g = lane >> 4, q4 = (lane & 15) >> 2, p4 = lane & 3, kp = tid & 63, part = tid >> 6;
    LAS float* BR = (LAS float*)(lds + HL_BR); LAS unsigned char* KH = lds + HL_KH; LAS unsigned char* VV = lds + HL_VV;
    u32x4 irr[2]; unsigned lf[8];
#define H4_LOAD(it_) do { const int b_ = (it_) >> 9, h_ = ((it_) >> 6) & 7, c_ = (it_) & 63; const size_t m_ = (size_t)b_ * SEQ + 64 * c_; \
        _Pragma("unroll") for (int i = 0; i < 2; ++i) { const int ch = tid + 512 * i, row = ch >> 4, c16 = ch & 15; irr[i] = *(const u32x4*)(IR + (m_ + row) * HW + h_ * 128 + c16 * 8); } \
        hgrn_lf_load(LF, m_, h_, tid, lf); } while (0)
    if ((int)blockIdx.x < 2048) H4_LOAD((int)blockIdx.x);
    for (int item = blockIdx.x; item < 2048; item += G) {
        __syncthreads();
#pragma unroll
        for (int i = 0; i < 2; ++i) { const int ch = tid + 512 * i, row = ch >> 4, c16 = ch & 15; *(LAS u32x4*)(VV + row * 288 + c16 * 16) = irr[i]; }
        float gl[8][2], bc[8][2];
        hgrn_cumsum(lf, lds, tid, gl, bc);
        if (part == 7) *(LAS f32x2*)(BR + 128 + 2 * kp) = (f32x2){bc[7][0], bc[7][1]};
        __syncthreads();
        const f32x2 bl = *(const LAS f32x2*)(BR + 128 + 2 * kp);
#pragma unroll
        for (int i = 0; i < 8; ++i) { const float k0 = (1.f - __expf(gl[i][0])) * __expf(bl.x - bc[i][0]), k1 = (1.f - __expf(gl[i][1])) * __expf(bl.y - bc[i][1]);
            *(LAS unsigned*)(KH + (8 * part + i) * 288 + kp * 4) = cvt_pk_bf16(k0, k1); }
        if (part == 7) *(f32x2*)(DEC + (size_t)item * 128 + 2 * kp) = (f32x2){__expf(bl.x), __expf(bl.y)};
        { const int nit = min(item + G, 2047); H4_LOAD(nit); }
        __syncthreads();
        f32x4 acc[8];
#pragma unroll
        for (int kt = 0; kt < 8; ++kt) acc[kt] = (f32x4){0.f, 0.f, 0.f, 0.f};
#pragma unroll
        for (int ss = 0; ss < 2; ++ss) { const int r0 = 32 * ss + 8 * g + q4;
            const bf16x8 af = tr_pair(VV + r0 * 288 + (16 * wave + 4 * p4) * 2, VV + (r0 + 4) * 288 + (16 * wave + 4 * p4) * 2);
#pragma unroll
            for (int kt = 0; kt < 8; ++kt) { const bf16x8 bf = tr_pair(KH + r0 * 288 + (16 * kt + 4 * p4) * 2, KH + (r0 + 4) * 288 + (16 * kt + 4 * p4) * 2);
                acc[kt] = __builtin_amdgcn_mfma_f32_16x16x32_bf16(af, bf, acc[kt], 0, 0, 0); } }
#pragma unroll
        for (int kt = 0; kt < 8; ++kt) { u32x2 w; w.x = cvt_pk_bf16(acc[kt][0], acc[kt][1]); w.y = cvt_pk_bf16(acc[kt][2], acc[kt][3]);
            *(u32x2*)(SU + ((size_t)item * 128 + 16 * kt + r16) * 128 + 16 * wave + 4 * g) = w; }
    }
}
#undef H4_LOAD
__device__ __forceinline__ void phase5_scan(const Args& a, int tid, int G) {
    const bf16* U = (const bf16*)a.out; bf16* Sb = (bf16*)a.out + (size_t)2048 * 128 * 128; const float* DEC = (const float*)(a.ws + WS_ARENA + A_DEC);
    for (int gid = blockIdx.x * 512 + tid; gid < 32 * 4096; gid += G * 512) {
        const int bh = gid >> 12, e4 = gid & 4095, k = e4 >> 5, v4 = (e4 & 31) * 4;
        float S0 = 0.f, S1 = 0.f, S2 = 0.f, S3 = 0.f;
        const size_t off = ((size_t)bh * 64 * 128 + k) * 128 + v4;
        const u32x2* pu = (const u32x2*)(U + off); u32x2* ps = (u32x2*)(Sb + off); const float* dp = DEC + (size_t)bh * 64 * 128 + k;
#pragma unroll 16
        for (int c = 0; c < 64; ++c) { const u32x2 u = pu[(size_t)c * 4096]; const float d = dp[c * 128];
            u32x2 w; w.x = cvt_pk_bf16(S0, S1); w.y = cvt_pk_bf16(S2, S3); ps[(size_t)c * 4096] = w;
            S0 = d * S0 + bflo(u.x); S1 = d * S1 + bfhi(u.x); S2 = d * S2 + bflo(u.y); S3 = d * S3 + bfhi(u.y); }
    }
}
__device__ __forceinline__ void phase6_hgrn(const Args& a, LAS unsigned char* lds, int tid, int lane, int wave, int G) {
    const bf16* QR = (const bf16*)(a.ws + WS_ARENA + A_QR); const bf16* IR = (const bf16*)(a.ws + WS_ARENA + A_IR); const bf16* LF = (const bf16*)(a.ws + WS_ARENA + A_LF);
    const bf16* SU = (const bf16*)a.out + (size_t)2048 * 128 * 128; const bf16* GR = (const bf16*)(a.ws + WS_ARENA + A_GR); const float* hn = a.in[I_HNORM];
    bf16* OREC = (bf16*)(a.ws + WS_ARENA + A_OATT);
    const int r16 = lane & 15, g = lane >> 4, q4 = (lane & 15) >> 2, p4 = lane & 3, kp = tid & 63, part = tid >> 6, tt = wave & 3, vh = wave >> 2;
    LAS float* BR = (LAS float*)(lds + HL_BR); LAS float* NR = (LAS float*)(lds + HL_NR);
    LAS unsigned char* QT = lds + HL_QT; LAS unsigned char* KT = lds + HL_KT; LAS unsigned char* QE = lds + HL_QE; LAS unsigned char* VV = lds + HL_VV; LAS unsigned char* SS = lds + HL_SS;
    u32x4 irr[2], sur[4]; unsigned lf[8], qwr[8];
#define H6_LOAD(it_) do { const int b_ = (it_) >> 9, h_ = ((it_) >> 6) & 7, c_ = (it_) & 63; const size_t m_ = (size_t)b_ * SEQ + 64 * c_; \
        _Pragma("unroll") for (int i = 0; i < 2; ++i) { const int ch = tid + 512 * i, row = ch >> 4, c16 = ch & 15; irr[i] = *(const u32x4*)(IR + (m_ + row) * HW + h_ * 128 + c16 * 8); } \
        _Pragma("unroll") for (int i = 0; i < 4; ++i) { const int ch = tid + 512 * i, row = ch >> 4, c16 = ch & 15; sur[i] = *(const u32x4*)(SU + ((size_t)(it_) * 128 + row) * 128 + c16 * 8); } \
        hgrn_lf_load(LF, m_, h_, tid, lf); \
        _Pragma("unroll") for (int i = 0; i < 8; ++i) qwr[i] = *(const unsigned*)(QR + (m_ + 8 * part + i) * HW + h_ * 128 + 2 * kp); } while (0)
    if ((int)blockIdx.x < 2048) H6_LOAD((int)blockIdx.x);
    for (int item = blockIdx.x; item < 2048; item += G) {
        const int b = item >> 9, h = (item >> 6) & 7, c = item & 63; const size_t m0 = (size_t)b * SEQ + 64 * c;
        __syncthreads();
#pragma unroll
        for (int i = 0; i < 2; ++i) { const int ch = tid + 512 * i, row = ch >> 4, c16 = ch & 15; *(LAS u32x4*)(VV + row * 288 + c16 * 16) = irr[i]; }
#pragma unroll
        for (int i = 0; i < 4; ++i) { const int ch = tid + 512 * i, row = ch >> 4, c16 = ch & 15; *(LAS u32x4*)(SS + row * 288 + c16 * 16) = sur[i]; }
        float gl[8][2], bc[8][2];
        hgrn_cumsum(lf, lds, tid, gl, bc);
        if (part == 3) *(LAS f32x2*)(BR + 2 * kp) = (f32x2){bc[7][0], bc[7][1]};
        __syncthreads();
        const f32x2 br = *(const LAS f32x2*)(BR + 2 * kp);
#pragma unroll
        for (int i = 0; i < 8; ++i) { const int t = 8 * part + i; const unsigned qw = qwr[i]; const float q0 = bflo(qw), q1 = bfhi(qw);
            const float f0 = __expf(gl[i][0]), f1 = __expf(gl[i][1]);
            *(LAS unsigned*)(QT + t * 272 + kp * 4) = cvt_pk_bf16(q0 * __expf(bc[i][0] - br.x), q1 * __expf(bc[i][1] - br.y));
            *(LAS unsigned*)(KT + t * 272 + kp * 4) = cvt_pk_bf16((1.f - f0) * __expf(br.x - bc[i][0]), (1.f - f1) * __expf(br.y - bc[i][1]));
            *(LAS unsigned*)(QE + t * 272 + kp * 4) = cvt_pk_bf16(q0 * __expf(bc[i][0]), q1 * __expf(bc[i][1])); }
        { const int nit = min(item + G, 2047); H6_LOAD(nit); }
        u32x2 grr[4]; f32x4 nnr[4];
#pragma unroll
        for (int vi = 0; vi < 4; ++vi) { const int col = h * 128 + 16 * (4 * vh + vi) + 4 * g; grr[vi] = *(const u32x2*)(GR + (m0 + 16 * tt + r16) * HW + col); nnr[vi] = *(const f32x4*)(hn + col); }
        __syncthreads();
        f32x4 sc[4];
#pragma unroll
        for (int st = 0; st < 4; ++st) { sc[st] = (f32x4){0.f, 0.f, 0.f, 0.f};
            if (st <= tt) {
#pragma unroll
                for (int kk = 0; kk < 4; ++kk) { const bf16x8 af = *(const LAS bf16x8*)(KT + (16 * st + r16) * 272 + (32 * kk + 8 * g) * 2), bf = *(const LAS bf16x8*)(QT + (16 * tt + r16) * 272 + (32 * kk + 8 * g) * 2);
                    sc[st] = __builtin_amdgcn_mfma_f32_16x16x32_bf16(af, bf, sc[st], 0, 0, 0); }
                if (st == tt) {
#pragma unroll
                    for (int i = 0; i < 4; ++i) sc[st][i] = (4 * g + i <= r16) ? sc[st][i] : 0.f; } } }
        bf16x8 pf[2]; pf[0] = pack_bf8(sc[0], sc[1]); pf[1] = pack_bf8(sc[2], sc[3]);
        f32x4 o[4]; float ssq = 0.f;
#pragma unroll
        for (int vi = 0; vi < 4; ++vi) { const int vt = 4 * vh + vi; o[vi] = (f32x4){0.f, 0.f, 0.f, 0.f};
#pragma unroll
            for (int pp = 0; pp < 2; ++pp) if (2 * pp <= tt) { const int r0 = 32 * pp + 4 * g + q4;
                const bf16x8 af = tr_pair(VV + r0 * 288 + (16 * vt + 4 * p4) * 2, VV + (r0 + 16) * 288 + (16 * vt + 4 * p4) * 2);
                o[vi] = __builtin_amdgcn_mfma_f32_16x16x32_bf16(af, pf[pp], o[vi], 0, 0, 0); }
#pragma unroll
            for (int kk = 0; kk < 4; ++kk) { const int r0 = 32 * kk + 8 * g + q4;
                const bf16x8 af = tr_pair(SS + r0 * 288 + (16 * vt + 4 * p4) * 2, SS + (r0 + 4) * 288 + (16 * vt + 4 * p4) * 2);
                const bf16x8 bf = *(const LAS bf16x8*)(QE + (16 * tt + r16) * 272 + (32 * kk + 8 * g) * 2);
                o[vi] = __builtin_amdgcn_mfma_f32_16x16x32_bf16(af, bf, o[vi], 0, 0, 0); }
            ssq += (o[vi][0] * o[vi][0] + o[vi][1] * o[vi][1]) + (o[vi][2] * o[vi][2] + o[vi][3] * o[vi][3]); }
        ssq += __shfl_xor(ssq, 16); ssq += __shfl_xor(ssq, 32);
        if (g == 0) NR[vh * 64 + 16 * tt + r16] = ssq;
        __syncthreads();
        const float rstd = rsqrtf((NR[16 * tt + r16] + NR[64 + 16 * tt + r16]) * (1.f / 128.f) + EPS);
        const size_t mrow = m0 + 16 * tt + r16;
#pragma unroll
        for (int vi = 0; vi < 4; ++vi) { const int col = h * 128 + 16 * (4 * vh + vi) + 4 * g; const u32x2 gr = grr[vi]; const f32x4 nn = nnr[vi];
            u32x2 w; w.x = cvt_pk_bf16(o[vi][0] * rstd * nn[0] * bflo(gr.x), o[vi][1] * rstd * nn[1] * bfhi(gr.x)); w.y = cvt_pk_bf16(o[vi][2] * rstd * nn[2] * bflo(gr.y), o[vi][3] * rstd * nn[3] * bfhi(gr.y));
            *(u32x2*)(OREC + mrow * 1536 + 512 + col) = w; }
    }
}
#undef H6_LOAD
__device__ __forceinline__ void phase6_attn_mix(const Args& a, int lane, int wave, int G) {
    const bf16* O12 = (const bf16*)(a.ws + WS_ARENA + A_O12); const float* LSE = (const float*)(a.ws + WS_ARENA + A_LSE); bf16* OATT = (bf16*)(a.ws + WS_ARENA + A_OATT);
    const int gw = blockIdx.x * 8 + wave, NGW = G * 8;
    for (int m = gw; m < T; m += NGW) {
        const int j = lane >> 4, d8 = (lane & 15) * 8;
        const float l0 = LSE[(size_t)m * 12 + j], l1 = LSE[(size_t)m * 12 + 4 + j], l2 = LSE[(size_t)m * 12 + 8 + j];
        const float mx = fmaxf(l0, fmaxf(l1, l2)); const float e0 = __expf(l0 - mx), e1 = __expf(l1 - mx), e2 = __expf(l2 - mx); const float inv = 1.f / (e0 + e1 + e2);
        const float w[3] = {e0 * inv, e1 * inv, e2 * inv};
        float o[8];
#pragma unroll
        for (int q = 0; q < 8; ++q) o[q] = 0.f;
#pragma unroll
        for (int g = 0; g < 3; ++g) { const u32x4 s = *(const u32x4*)(O12 + (size_t)m * ATT_W + (4 * g + j) * 128 + d8);
            o[0] += w[g] * bflo(s.x); o[1] += w[g] * bfhi(s.x); o[2] += w[g] * bflo(s.y); o[3] += w[g] * bfhi(s.y);
            o[4] += w[g] * bflo(s.z); o[5] += w[g] * bfhi(s.z); o[6] += w[g] * bflo(s.w); o[7] += w[g] * bfhi(s.w); }
        u32x4 r; r.x = cvt_pk_bf16(o[0], o[1]); r.y = cvt_pk_bf16(o[2], o[3]); r.z = cvt_pk_bf16(o[4], o[5]); r.w = cvt_pk_bf16(o[6], o[7]);
        *(u32x4*)(OATT + (size_t)m * 1536 + j * 128 + d8) = r;
    }
}

constexpr int R9_ROWB = 4112;
constexpr int R9_PART = 16 * R9_ROWB;
constexpr int R9_PRM = R9_PART + 32768 + 8192;
constexpr int R9_RT = R9_PART + 32768;
struct RouteSel { bool sel; int rank; float w; };
__device__ __forceinline__ RouteSel route_token(float logit, int lane, float bias) {
    int e = lane; asm volatile("" : "+v"(e)); const int grp = e >> 3;
    const float score = 1.f / (1.f + expf(-logit)); const float choice = score + bias;
    int rg = 0;
#pragma unroll
    for (int d = 1; d < 8; ++d) { const int oe = (e & ~7) | ((e + d) & 7); const float ov = __shfl(choice, oe); rg += (ov > choice || (ov == choice && oe < e)) ? 1 : 0; }
    float gs = rg < 2 ? choice : 0.f; gs += __shfl_xor(gs, 1); gs += __shfl_xor(gs, 2); gs += __shfl_xor(gs, 4);
    int grank = 0;
#pragma unroll
    for (int d = 1; d < 8; ++d) { const int og = (grp + d) & 7; const float ogs = __shfl(gs, og * 8); grank += (ogs > gs || (ogs == gs && og < grp)) ? 1 : 0; }
    const float masked = grank < 4 ? choice : -INFINITY;
    int rank = 0;
#pragma unroll
    for (int j = 0; j < 64; ++j) { const float ov = __builtin_bit_cast(float, __builtin_amdgcn_readlane(__builtin_bit_cast(int, masked), j)); rank += (ov > masked || (ov == masked && j < e)) ? 1 : 0; }
    RouteSel r; r.sel = rank < 8; r.rank = rank;
    const float ssum = wave_sum(r.sel ? score : 0.f);
    r.w = score / ssum * 2.5f;
    return r;
}
__device__ __forceinline__ void phase9(const Args& a, LAS unsigned char* lds, int tid, int lane, int wave, int G) {
    const float* x = a.in[I_X]; const bf16* Y = (const bf16*)(a.ws + WS_ARENA + A_Y); const float* g2 = a.in[I_POST_MIX]; const float* g3 = a.in[I_PRE_FFN];
    const float* modf = (const float*)(a.ws + WS_MODF); unsigned char* H2F = a.ws + WS_ARENA + A_H2F; bf16* X1 = (bf16*)(a.ws + WS_ARENA + A_X1);
    const bf16* WR = (const bf16*)(a.ws + WS_WR); const float* rbias = a.in[I_RBIAS];
    int* TOPI = (int*)(a.ws + WS_TOPI); float* TOPW = (float*)(a.ws + WS_TOPW); int* TOPP = (int*)(a.ws + WS_TOPP); unsigned* cnt = (unsigned*)(a.ws + WS_CTL) + CW_CNT; int* LIST = (int*)(a.ws + WS_ARENA + A_LIST);
    const int r16 = lane & 15, g = lane >> 4; const float bias = rbias[lane];
    LAS float* PART = (LAS float*)(lds + R9_PART); LAS float* PA = (LAS float*)(lds + R9_PRM); LAS float* PB = PA + 2048; LAS float* PC = PB + 2048;
    LAS int* RCNT = (LAS int*)(lds + R9_RT); LAS int* RBASE = RCNT + 64; LAS int* RE = RBASE + 64; LAS float* RW = (LAS float*)(RE + 512); LAS int* RP = (LAS int*)(RW + 512);
    bf16x8 wrr[8][3];
#pragma unroll
    for (int ks = 0; ks < 8; ++ks)
#pragma unroll
        for (int et = 0; et < 3; ++et) wrr[ks][et] = *(const bf16x8*)(WR + (size_t)(16 * et + r16) * D + 256 * wave + 32 * ks + 8 * g);
    for (int gb = blockIdx.x; gb < T / 16; gb += 4 * G) {
        __syncthreads();
        { int t1 = tid; asm volatile("" : "+v"(t1)); if (t1 < 64) RCNT[t1] = 0; RE[t1] = -1; }
        u32x2 yw[8];
        { const char* yb = (const char*)(Y + (size_t)(gb * 16 + wave) * D);
#pragma unroll
          for (int j = 0; j < 8; ++j) yw[j] = *(const u32x2*)(yb + ((unsigned)lane * 8u + 512u * j)); }
#pragma unroll 1
        for (int q = 0; q < 4; ++q) {
            const int grp = gb + q * G; if (grp >= T / 16) break;
            const int m0 = grp * 16;
            int ln = lane; asm volatile("" : "+v"(ln));
            const int b = m0 / SEQ; const float* mbf = modf + (size_t)b * 12288;
            __syncthreads();
            {
                int tl = tid; asm volatile("" : "+v"(tl)); const int c = tl * 4; const f32x4 p2 = *(const f32x4*)(g2 + c), pm = *(const f32x4*)(mbf + 4096 + c), p3 = *(const f32x4*)(g3 + c), ph = *(const f32x4*)(mbf + 6144 + c), pc = *(const f32x4*)(mbf + 8192 + c);
                f32x4 qa, qb;
#pragma unroll
                for (int k = 0; k < 4; ++k) { qa[k] = p2[k] * pm[k]; qb[k] = p3[k] * (1.f + pc[k]); }
                *(LAS f32x4*)(PA + c) = qa; *(LAS f32x4*)(PB + c) = qb; *(LAS f32x4*)(PC + c) = ph; }
            __syncthreads();
#pragma unroll
            for (int it = 0; it < 2; ++it) {
                const int m = m0 + 8 * it + wave;
                const char* xb = (const char*)(x + (size_t)m * D); char* ob = (char*)(X1 + (size_t)m * D); char* hb = (char*)(H2F + (size_t)m * D);
                const unsigned o16 = (unsigned)ln * 16u, o8 = (unsigned)ln * 8u, o4 = (unsigned)ln * 4u;
                f32x4 xv[8];
#pragma unroll
                for (int j = 0; j < 8; ++j) xv[j] = *(const f32x4*)(xb + (o16 + 1024u * j));
                float ss = 0.f;
#pragma unroll
                for (int j = 0; j < 8; ++j) { const u32x2 w_ = yw[j]; const f32x4 y_ = (f32x4){bflo(w_.x), bfhi(w_.x), bflo(w_.y), bfhi(w_.y)}; ss += (y_[0] * y_[0] + y_[1] * y_[1]) + (y_[2] * y_[2] + y_[3] * y_[3]); }
                const float rstd = rsqrtf(wave_sum(ss) * (1.f / D) + EPS);
                float ss2 = 0.f;
                f32x4 (&v)[8] = xv;
#pragma unroll
                for (int j = 0; j < 8; ++j) { const f32x4 pa = *(const LAS f32x4*)(PA + 4 * ln + 256 * j); const u32x2 w_ = yw[j]; const f32x4 y_ = (f32x4){bflo(w_.x), bfhi(w_.x), bflo(w_.y), bfhi(w_.y)};
#pragma unroll
                    for (int qq = 0; qq < 4; ++qq) v[j][qq] = xv[j][qq] + pa[qq] * (y_[qq] * rstd);
                    ss2 += (v[j][0] * v[j][0] + v[j][1] * v[j][1]) + (v[j][2] * v[j][2] + v[j][3] * v[j][3]);
                    { u32x2 w1; w1.x = cvt_pk_bf16(v[j][0], v[j][1]); w1.y = cvt_pk_bf16(v[j][2], v[j][3]); *(u32x2*)(ob + (o8 + 512u * j)) = w1; } }
                if (it == 0) { const char* yb = (const char*)(Y + (size_t)(m0 + 8 + wave) * D);
#pragma unroll
                    for (int j = 0; j < 8; ++j) yw[j] = *(const u32x2*)(yb + ((unsigned)ln * 8u + 512u * j)); }
                const float rstd2 = rsqrtf(wave_sum(ss2) * (1.f / D) + EPS);
                LAS unsigned char* hrow = lds + (8 * it + wave) * R9_ROWB;
#pragma unroll
                for (int j = 0; j < 8; ++j) { const f32x4 pb = *(const LAS f32x4*)(PB + 4 * ln + 256 * j), pc = *(const LAS f32x4*)(PC + 4 * ln + 256 * j);
                    f32x4 h;
#pragma unroll
                    for (int qq = 0; qq < 4; ++qq) h[qq] = v[j][qq] * rstd2 * pb[qq] + pc[qq];
                    u32x2 w; w.x = cvt_pk_bf16(h[0], h[1]); w.y = cvt_pk_bf16(h[2], h[3]);
                    *(LAS u32x2*)(hrow + (o8 + 512u * j)) = w;
                    *(unsigned*)(hb + (o4 + 256u * j)) = pk4_fp8(h[0], h[1], h[2], h[3]); }
            }
            { const int gn = (q < 3 && grp + G < T / 16) ? grp + G : grp;
              const char* yb = (const char*)(Y + (size_t)(gn * 16 + wave) * D);
#pragma unroll
              for (int j = 0; j < 8; ++j) yw[j] = *(const u32x2*)(yb + ((unsigned)ln * 8u + 512u * j)); }
            __syncthreads();
            {
                f32x4 acc[4];
#pragma unroll
                for (int et = 0; et < 4; ++et) acc[et] = (f32x4){0.f, 0.f, 0.f, 0.f};
#pragma unroll
                for (int ks = 0; ks < 8; ++ks) { const int k = 256 * wave + 32 * ks + 8 * g;
                    const bf16x8 af = *(const LAS bf16x8*)(lds + r16 * R9_ROWB + k * 2);
#pragma unroll
                    for (int et = 0; et < 4; ++et) { bf16x8 bf; if (et < 3) bf = wrr[ks][et]; else bf = *(const bf16x8*)(WR + (size_t)(16 * et + r16) * D + k);
                        acc[et] = __builtin_amdgcn_mfma_f32_16x16x32_bf16(af, bf, acc[et], 0, 0, 0); } }
#pragma unroll
                for (int et = 0; et < 4; ++et)
#pragma unroll
                    for (int i = 0; i < 4; ++i) PART[(wave * 16 + 4 * g + i) * 64 + 16 * et + r16] = acc[et][i];
            }
            __syncthreads();
#pragma unroll
            for (int tt = 0; tt < 2; ++tt) { const int tok = 2 * wave + tt; float logit = 0.f;
#pragma unroll
                for (int w = 0; w < 8; ++w) logit += PART[(w * 16 + tok) * 64 + lane];
                const RouteSel r = route_token(logit, lane, bias);
                if (r.sel) { const int slot = (q * 16 + tok) * 8 + r.rank;
                    RE[slot] = lane; RW[slot] = r.w; RP[slot] = __hip_atomic_fetch_add(RCNT + lane, 1, __ATOMIC_RELAXED, __HIP_MEMORY_SCOPE_WORKGROUP); } }
        }
        __syncthreads();
        int t2 = tid; asm volatile("" : "+v"(t2));
        if (t2 < 64) RBASE[t2] = (int)atomicAdd(&cnt[t2], (unsigned)RCNT[t2]);
        __syncthreads();
        {   const int e = RE[t2];
            if (e >= 0) { const int grp = gb + (t2 >> 7) * G; const int m = grp * 16 + ((t2 >> 3) & 15); const int pos = RBASE[e] + RP[t2];
                TOPI[(size_t)m * 8 + (t2 & 7)] = e; TOPW[(size_t)m * 8 + (t2 & 7)] = RW[t2]; TOPP[(size_t)m * 8 + (t2 & 7)] = pos; LIST[(size_t)e * T + pos] = m; } }
    }
}

__device__ __forceinline__ void phase15(const Args& a, LAS unsigned char* lds, int tid, int lane, int wave, int G) {
    const unsigned char* YS = a.ws + WS_ARENA + A_YS; const int* TOPI = (const int*)(a.ws + WS_TOPI); const int* TOPP = (const int*)(a.ws + WS_TOPP); const float* TOPW = (const float*)(a.ws + WS_TOPW); const float* g4 = a.in[I_POST_FFN];
    LAS int* ST = (LAS int*)lds;
    __syncthreads();
    if (tid < 64) pg8::moe_tables((const unsigned*)(a.ws + WS_CTL) + CW_CNT, ST, tid);
    __syncthreads();
    const float* modf = (const float*)(a.ws + WS_MODF); float* out = a.out; const bf16* X1 = (const bf16*)(a.ws + WS_ARENA + A_X1);
    const int gw = blockIdx.x * 8 + wave, NGW = G * 8;
    i32x4 ne0, ne1, np0, np1;
    if (gw < T) { ne0 = *(const i32x4*)(TOPI + (size_t)gw * 8); ne1 = *(const i32x4*)(TOPI + (size_t)gw * 8 + 4); np0 = *(const i32x4*)(TOPP + (size_t)gw * 8); np1 = *(const i32x4*)(TOPP + (size_t)gw * 8 + 4); }
    for (int m = gw; m < T; m += NGW) {
        const int b = m / SEQ; const float* mb = modf + (size_t)b * 12288 + 10240;
        float acc[2][16];
#pragma unroll
        for (int j = 0; j < 2; ++j)
#pragma unroll
            for (int q = 0; q < 16; ++q) acc[j][q] = 0.f;
        int slots[9];
        { const i32x4 e0 = ne0, e1 = ne1, p0 = np0, p1 = np1;
#pragma unroll
          for (int q = 0; q < 4; ++q) { slots[q] = ST[e0[q]] + p0[q]; slots[4 + q] = ST[e1[q]] + p1[q]; }
          slots[8] = T * 8 + m;
          const size_t mn = (size_t)(m + NGW < T ? m + NGW : m);
          ne0 = *(const i32x4*)(TOPI + mn * 8); ne1 = *(const i32x4*)(TOPI + mn * 8 + 4); np0 = *(const i32x4*)(TOPP + mn * 8); np1 = *(const i32x4*)(TOPP + mn * 8 + 4); }
#pragma unroll 3
        for (int k = 0; k < 9; ++k) { const int slot = slots[k]; const float wk = (k < 8) ? TOPW[(size_t)m * 8 + k] : 1.0f; const u32x4* r = (const u32x4*)(YS + (size_t)slot * D) + lane;
#pragma unroll
            for (int j = 0; j < 2; ++j) { const u32x4 s = r[64 * j]; const unsigned w4[4] = {s.x, s.y, s.z, s.w};
#pragma unroll
                for (int q = 0; q < 4; ++q) { const f32x2 lo = __builtin_amdgcn_cvt_pk_f32_fp8((int)w4[q], false), hi = __builtin_amdgcn_cvt_pk_f32_fp8((int)w4[q], true);
                    acc[j][4 * q] += wk * lo.x; acc[j][4 * q + 1] += wk * lo.y; acc[j][4 * q + 2] += wk * hi.x; acc[j][4 * q + 3] += wk * hi.y; } } }
        float ss = 0.f;
#pragma unroll
        for (int j = 0; j < 2; ++j)
#pragma unroll
            for (int q = 0; q < 16; ++q) ss += acc[j][q] * acc[j][q];
        const float rstd = rsqrtf(wave_sum(ss) * (1.f / (D * SC_YS * SC_YS)) + EPS);
        const float rs = rstd * (1.f / SC_YS);
#pragma unroll
        for (int j = 0; j < 2; ++j) { const int cidx = 16 * lane + 1024 * j; float* op = out + (size_t)m * D + cidx;
#pragma unroll
            for (int hh = 0; hh < 4; ++hh) { const f32x4 g = *(const f32x4*)(g4 + cidx + 4 * hh), gf = *(const f32x4*)(mb + cidx + 4 * hh); const u32x2 xw = *(const u32x2*)(X1 + (size_t)m * D + cidx + 4 * hh); f32x4 o = (f32x4){bflo(xw.x), bfhi(xw.x), bflo(xw.y), bfhi(xw.y)};
#pragma unroll
                for (int q = 0; q < 4; ++q) o[q] += gf[q] * (acc[j][4 * hh + q] * rs * g[q]);
                *(f32x4*)(op + 4 * hh) = o; } }
    }
}

__global__ void __launch_bounds__(512, 2) fwd(Args args) {
    extern __shared__ __attribute__((aligned(16))) unsigned char lds_raw[];
    LAS unsigned char* lds = (LAS unsigned char*)lds_raw;
    volatile LAS unsigned* MISC = (volatile LAS unsigned*)(lds + MISC_OFF);
    const int tid = threadIdx.x, lane = tid & 63, wave = __builtin_amdgcn_readfirstlane(tid >> 6), G = gridDim.x;
    unsigned char* ws = args.ws;
    unsigned* ctl = (unsigned*)(ws + WS_CTL);
    for (int u = tid; u < (LDS_BYTES - MISC_OFF) / 4; u += 512) ((LAS unsigned*)(lds + MISC_OFF))[u] = (u == 16) ? CHW : (u == 17) ? 0xFFFFFFFFu : 0u;
    __syncthreads();
    const int lo = args.ph_lo, hi = args.ph_hi;
    XcdBarrier bar; bar.bar = ctl + CW_BAR; bar.x = 0; bar.st = nullptr;
    if (hi - lo > 1) bar = xcd_barrier_post(ctl + CW_BAR, MISC + 8);
#define IN(k) (lo <= (k) && (k) < hi)
#define SEAM(k) do { if (IN(k) && IN((k) + 1)) xcd_barrier(bar); } while (0)
    unsigned char* ar = ws + WS_ARENA;

    if (IN(0)) { phase0(args, lds, tid, lane, wave, G); } SEAM(0);
    if (IN(1)) { phase1(args, tid, G); } SEAM(1);
    if (IN(2)) { phase2(args, lds, tid, lane, wave, G); } SEAM(2);
    const int NCONV = (G >= 128) ? N_CONV_WG : 0;
    if (IN(3)) {
        unsigned* done = ctl + CW_DONE;
        if ((int)blockIdx.x >= NCONV) {
            const int Gg = G - NCONV, cg = (int)blockIdx.x - NCONV;
            {
                pg8::DenseSched S{(const char*)(ar + A_H), (const char*)(ar + A_WTIN) + (size_t)4608 * D * 2, D * 2, D * 2, D / 64, T / 256, 16, 1, Gg, cg};
                pg8::EpiProj E{(bf16*)(ar + A_QKV), (bf16*)(ar + A_QR), (bf16*)(ar + A_LF), (bf16*)(ar + A_IR), (bf16*)(ar + A_GR), (bf16*)(ar + A_SA), (bf16*)(ar + A_SB), args.in[I_LBL], 18};
                pg8::gemm_phase<pg8::EpiProj, pg8::DenseSched, true>(lds, S, E); }
            {
                pg8::DenseSched S{(const char*)(ar + A_H8), (const char*)(ar + A_WTIN), D, D, D / 128, T / 256, 18, 1, Gg, Gg - 1 - cg, 0x77777777};
                pg8::EpiProj E{(bf16*)(ar + A_QKV), (bf16*)(ar + A_QR), (bf16*)(ar + A_LF), (bf16*)(ar + A_IR), (bf16*)(ar + A_GR), (bf16*)(ar + A_SA), (bf16*)(ar + A_SB), args.in[I_LBL], 0};
                pg8::gemm_phase<pg8::EpiProj, pg8::DenseSched, true, true>(lds, S, E); }
            if (tid == 0) atomicAdd(done, 1u);
        }
        if (IN(4)) conv_queue_until(args, lds, lane, wave, MISC + 16, done, (unsigned)(G - NCONV));
        else conv_queue(args, lds, lane, wave, MISC + 16);
    } SEAM(3);
    if (IN(4)) {
        if ((int)blockIdx.x >= NCONV) {
            const int cg = (int)blockIdx.x - NCONV; const bool gemm_first = ((cg >> 3) & 1) == 0;
            if (!gemm_first) { phase4_hgrn(args, lds, tid, lane, wave, G); phase4_attn(args, lds, tid, lane, wave, G); __syncthreads(); }
            { pg8::DenseSched S{(const char*)(ar + A_H8), (const char*)(ar + A_WG8), D, D, D / 128, T / 256, 16, 1, G - NCONV, cg, 0x77777777};
              pg8::EpiGate E{(unsigned char*)(ar + A_SA), (unsigned char*)(ar + A_SB)};
              pg8::gemm_phase<pg8::EpiGate, pg8::DenseSched, true, true>(lds, S, E); }
            if (gemm_first) { phase4_hgrn(args, lds, tid, lane, wave, G); phase4_attn(args, lds, tid, lane, wave, G); __syncthreads(); }
        } else { phase4_hgrn(args, lds, tid, lane, wave, G); phase4_attn(args, lds, tid, lane, wave, G); __syncthreads(); }
        conv_queue(args, lds, lane, wave, MISC + 16);
    } SEAM(4);
    if (IN(5)) { phase5_scan(args, tid, G); } SEAM(5);
    if (IN(6)) { phase6_hgrn(args, lds, tid, lane, wave, G); phase6_attn_mix(args, lane, wave, G); } SEAM(6);
    if (IN(7)) {
        pg8::DenseSched S{(const char*)(ar + A_OATT), (const char*)(ar + A_WBA), 1536 * 2, 1536 * 2, 1536 / 64, T / 256, D / 256, 1, G, (int)blockIdx.x};
        pg8::EpiMerged E{(const unsigned char*)(ar + A_SA), (const unsigned char*)(ar + A_SB), (unsigned char*)(ar + A_MERGED)};
        pg8::gemm_phase<pg8::EpiMerged, pg8::DenseSched, true>(lds, S, E);
    } SEAM(7);
    if (IN(8)) {
        pg8::DenseSched S{(const char*)(ar + A_MERGED), (const char*)(ar + A_WOUT), D, D, D / 128, T / 256, D / 256, 1, G, (int)blockIdx.x, 0x73737373};
        pg8::EpiF32 E{(bf16*)(ar + A_Y)};
        pg8::gemm_phase<pg8::EpiF32, pg8::DenseSched, true, true>(lds, S, E);
    } SEAM(8);
    if (IN(9)) { phase9(args, lds, tid, lane, wave, G); }
    if (IN(9) && IN(13)) xcd_barrier(bar);
    if (IN(13)) {
        pg8::MoeSched S{(const char*)(ar + A_H2F), (const int*)(ar + A_LIST), (const char*)(ws + WS_WGU), (size_t)1024 * 2048, D, D, D / 128, 4, (const unsigned*)(ws + WS_CTL) + CW_CNT, 0, G, (int)blockIdx.x, 0x77777777, lds};
        S.prepare();
        pg8::EpiSwiglu E{(unsigned char*)(ar + A_HID)};
        pg8::gemm_phase<pg8::EpiSwiglu, pg8::MoeSched, true, true>(lds, S, E);
    } SEAM(13);
    if (IN(14)) {
        pg8::MoeSched S{(const char*)(ar + A_HID), nullptr, (const char*)(ws + WS_WD), (size_t)2048 * 512, DE, DE, DE / 128, 8, (const unsigned*)(ws + WS_CTL) + CW_CNT, 0, G, (int)blockIdx.x, 0x7C7C7C7C, lds};
        S.prepare();
        pg8::EpiDown E{(unsigned char*)(ar + A_YS)};
        pg8::gemm_phase<pg8::EpiDown, pg8::MoeSched, true, true>(lds, S, E);
    } SEAM(14);
    if (IN(15)) { phase15(args, lds, tid, lane, wave, G); }
#undef IN
#undef SEAM
}

extern "C" void kernel_launch(void* const* d_in, const int* in_sizes, int n_in, void* d_out, int out_size, void* d_ws, size_t ws_size, hipStream_t stream) {
    static int grid = 0;
    if (grid == 0) {
        if (n_in != 22 || ws_size < WS_END) { fprintf(stderr, "kernel_launch: unexpected inputs (n_in %d, ws %zu < %zu)\n", n_in, ws_size, (size_t)WS_END); grid = -1; return; }
        int dev = 0, cus = 0, per_cu = 0;
        if (hipGetDevice(&dev) != hipSuccess || hipDeviceGetAttribute(&cus, hipDeviceAttributeMultiprocessorCount, dev) != hipSuccess) { grid = -1; return; }
        if (hipFuncSetAttribute((const void*)fwd, hipFuncAttributeMaxDynamicSharedMemorySize, LDS_BYTES) != hipSuccess) { fprintf(stderr, "kernel_launch: hipFuncSetAttribute failed\n"); grid = -1; return; }
        if (hipOccupancyMaxActiveBlocksPerMultiprocessor(&per_cu, (const void*)fwd, 512, LDS_BYTES) != hipSuccess || per_cu < 1) fprintf(stderr, "kernel_launch: occupancy query says %d\n", per_cu);
        (void)hipGetLastError();
        grid = cus;
    }
    if (grid < 0) return;
    (void)hipMemsetAsync((char*)d_ws + WS_CTL, 0, CTL_ZERO_BYTES, stream);
    Args a{};
    for (int i = 0; i < 22; ++i) a.in[i] = (const float*)d_in[i];
    a.out = (float*)d_out; a.ws = (unsigned char*)d_ws;
    constexpr int NL = MK_N_LAUNCHES;
    for (int li = 0; li < NL; ++li) {
        a.ph_lo = (NL == 1) ? 0 : li; a.ph_hi = (NL == 1) ? NPH : li + 1;
        if (NL != 1 && (li == 10 || li == 11 || li == 12)) continue;
        hipLaunchKernelGGL(fwd, dim3(grid), dim3(512), LDS_BYTES, stream, a);
    }
}
```
